# Optimizing an MI355X kernel written in HIP

```python
import jax, jax.numpy as jnp
from jax import lax
import numpy as np

D_MODEL = 1024
BATCH = 1
SEQ = 16384
DEPTH = 1
DEC_BATCH = 8
DEC_SEQ = 16
PAST_LEN = 1024

CHUNK = 64
LEFT_CHUNKS = 8
BAND_CHUNKS = LEFT_CHUNKS + 1
BAND_PAST = LEFT_CHUNKS * CHUNK
D_MIX = D_MODEL
D_ATTN = D_MIX // 2
D_CONV = D_MIX - D_ATTN
ATT_HEADS = 8
ATT_HEAD_DIM = D_ATTN // ATT_HEADS
REL_CLIP = 128
CONV_WIDTH = 31
CONV_GROUPS = 8
MEM_TOKENS = 256
MEM_HEADS = 4
MEM_HEAD_DIM = D_MODEL // MEM_HEADS
D_FF = 4 * D_MODEL
EPS = 1e-6
NEG_INF = -1e30

kernel_name = "hybrid_chunk_band_attn_conformer_conv_step"


def rms_norm(x, g):
    x32 = x.astype(jnp.float32)
    y = x32 * lax.rsqrt(jnp.mean(x32 * x32, axis=-1, keepdims=True) + EPS)
    return (y * g.astype(jnp.float32)).astype(x.dtype)


def group_layer_norm(u, g, b):
    shp = u.shape
    u32 = u.astype(jnp.float32).reshape(shp[:-1] + (CONV_GROUPS, D_CONV // CONV_GROUPS))
    mu = jnp.mean(u32, axis=-1, keepdims=True)
    var = jnp.mean(jnp.square(u32 - mu), axis=-1, keepdims=True)
    y = ((u32 - mu) * lax.rsqrt(var + EPS)).reshape(shp)
    return (y * g.astype(jnp.float32) + b.astype(jnp.float32)).astype(u.dtype)


def rel_bias(table, q_off, k_off):
    d = q_off[:, None] - k_off[None, :]
    idx = jnp.clip(d, -REL_CLIP, REL_CLIP) + REL_CLIP
    return table[:, idx]


def in_proj(xn, w_in):
    B, T, _ = xn.shape
    z = xn @ w_in
    q, k, v, ga, gb = jnp.split(z, [D_ATTN, 2 * D_ATTN, 3 * D_ATTN, 3 * D_ATTN + D_CONV], axis=-1)
    heads = lambda t: t.reshape(B, T, ATT_HEADS, ATT_HEAD_DIM)
    u = ga * jax.nn.sigmoid(gb)
    return heads(q), heads(k), heads(v), u


def band_attn_prompt(q, k, v, table):
    B, S, H, Dh = q.shape
    NC = S // CHUNK
    pad = ((0, 0), (BAND_PAST, 0), (0, 0), (0, 0))
    kp = jnp.pad(k, pad)
    vp = jnp.pad(v, pad)

    def band(t):
        return jnp.stack(
            [t[:, j * CHUNK: j * CHUNK + S].reshape(B, NC, CHUNK, H, Dh) for j in range(BAND_CHUNKS)],
            axis=2).reshape(B, NC, BAND_CHUNKS * CHUNK, H, Dh)

    kb, vb = band(kp), band(vp)
    qc = q.reshape(B, NC, CHUNK, H, Dh)
    s = jnp.einsum('bnqhd,bnkhd->bnhqk', qc, kb).astype(jnp.float32) * (Dh ** -0.5)
    q_off = jnp.arange(CHUNK) + BAND_PAST
    k_off = jnp.arange(BAND_CHUNKS * CHUNK)
    s = s + rel_bias(table, q_off, k_off).astype(jnp.float32)[None, None]
    chunk_valid = (jnp.arange(NC)[:, None] + jnp.arange(BAND_CHUNKS)[None, :]) >= LEFT_CHUNKS
    key_valid = jnp.repeat(chunk_valid, CHUNK, axis=1)
    s = jnp.where(key_valid[None, :, None, None, :], s, NEG_INF)
    p = jax.nn.softmax(s, axis=-1).astype(v.dtype)
    o = jnp.einsum('bnhqk,bnkhd->bnqhd', p, vb)
    return o.reshape(B, S, H * Dh)


def band_attn_sample(q, k_all, v_all, table):
    B, T, H, Dh = q.shape
    L = k_all.shape[1]
    past = L - T
    s = jnp.einsum('bqhd,bkhd->bhqk', q, k_all).astype(jnp.float32) * (Dh ** -0.5)
    s = s + rel_bias(table, jnp.arange(T) + past, jnp.arange(L)).astype(jnp.float32)[None]
    p = jax.nn.softmax(s, axis=-1).astype(v_all.dtype)
    o = jnp.einsum('bhqk,bkhd->bqhd', p, v_all)
    return o.reshape(B, T, H * Dh)


def conv_branch(u_ext, w_dw, b_dw, ln_g, ln_b):
    c = lax.conv_general_dilated(
        u_ext, w_dw[:, None, :], window_strides=(1,), padding='VALID',
        dimension_numbers=('NWC', 'WIO', 'NWC'), feature_group_count=D_CONV) + b_dw
    return jax.nn.silu(group_layer_norm(c, ln_g, ln_b))


def merge_out(a, c, g_attn_out, g_conv_out, w_out):
    return jnp.concatenate([rms_norm(a, g_attn_out), rms_norm(c, g_conv_out)], axis=-1) @ w_out


def mem_kv(mem, g_mem, wk, wv):
    B, M, _ = mem.shape
    mn = rms_norm(mem, g_mem)
    return ((mn @ wk).reshape(B, M, MEM_HEADS, MEM_HEAD_DIM),
            (mn @ wv).reshape(B, M, MEM_HEADS, MEM_HEAD_DIM))


def mem_attn(hn, mk, mv, wq, wo):
    B, T, _ = hn.shape
    q = (hn @ wq).reshape(B, T, MEM_HEADS, MEM_HEAD_DIM)
    s = jnp.einsum('bqhd,bmhd->bhqm', q, mk).astype(jnp.float32) * (MEM_HEAD_DIM ** -0.5)
    p = jax.nn.softmax(s, axis=-1).astype(mv.dtype)
    o = jnp.einsum('bhqm,bmhd->bqhd', p, mv).reshape(B, T, MEM_HEADS * MEM_HEAD_DIM)
    return o @ wo


def sq_relu_mlp(hn, w_up, w_down):
    return jnp.square(jax.nn.relu(hn @ w_up)) @ w_down


def setup_inputs(seed: int = 0) -> dict:
    key = jax.random.key(seed)
    ks = iter(jax.random.split(key, 40))
    nrm = lambda shape, scale: jax.random.normal(next(ks), shape, jnp.float32) * scale
    gain = lambda n: 1.0 + nrm((DEPTH, n), 0.02)
    keep = min(BAND_PAST, PAST_LEN)
    return {
        "x_prompt": nrm((BATCH, SEQ, D_MODEL), 1.0),
        "x_sample": nrm((DEC_BATCH, DEC_SEQ, D_MODEL), 1.0),
        "mem_prompt": nrm((BATCH, MEM_TOKENS, D_MODEL), 1.0),
        "cache_attn_k": nrm((DEPTH, DEC_BATCH, keep, ATT_HEADS, ATT_HEAD_DIM), 1.0),
        "cache_attn_v": nrm((DEPTH, DEC_BATCH, keep, ATT_HEADS, ATT_HEAD_DIM), 1.0),
        "cache_conv": nrm((DEPTH, DEC_BATCH, CONV_WIDTH - 1, D_CONV), 1.0),
        "cache_mem_k": nrm((DEPTH, DEC_BATCH, MEM_TOKENS, MEM_HEADS, MEM_HEAD_DIM), 1.0),
        "cache_mem_v": nrm((DEPTH, DEC_BATCH, MEM_TOKENS, MEM_HEADS, MEM_HEAD_DIM), 1.0),
        "g_mix_pre": gain(D_MODEL),
        "w_in": nrm((DEPTH, D_MODEL, 3 * D_ATTN + 2 * D_CONV), D_MODEL ** -0.5),
        "att_rel_bias": nrm((DEPTH, ATT_HEADS, 2 * REL_CLIP + 1), 0.1),
        "w_dw": nrm((DEPTH, CONV_WIDTH, D_CONV), CONV_WIDTH ** -0.5),
        "b_dw": nrm((DEPTH, D_CONV), 0.02),
        "conv_ln_g": gain(D_CONV),
        "conv_ln_b": nrm((DEPTH, D_CONV), 0.02),
        "g_attn_out": gain(D_ATTN),
        "g_conv_out": gain(D_CONV),
        "w_out": nrm((DEPTH, D_MIX, D_MODEL), D_MIX ** -0.5),
        "g_mix_post": gain(D_MODEL),
        "g_mem_pre": gain(D_MODEL),
        "g_mem_kv": gain(D_MODEL),
        "w_mem_q": nrm((DEPTH, D_MODEL, MEM_HEADS * MEM_HEAD_DIM), D_MODEL ** -0.5),
        "w_mem_k": nrm((DEPTH, D_MODEL, MEM_HEADS * MEM_HEAD_DIM), D_MODEL ** -0.5),
        "w_mem_v": nrm((DEPTH, D_MODEL, MEM_HEADS * MEM_HEAD_DIM), D_MODEL ** -0.5),
        "w_mem_o": nrm((DEPTH, MEM_HEADS * MEM_HEAD_DIM, D_MODEL), D_MODEL ** -0.5),
        "g_mem_post": gain(D_MODEL),
        "g_ffn_pre": gain(D_MODEL),
        "w_ffn_up": nrm((DEPTH, D_MODEL, D_FF), D_MODEL ** -0.5),
        "w_ffn_down": nrm((DEPTH, D_FF, D_MODEL), D_FF ** -0.5),
        "g_ffn_post": gain(D_MODEL),
    }


def reference(x_prompt, x_sample, mem_prompt, cache_attn_k, cache_attn_v, cache_conv, cache_mem_k, cache_mem_v,
              g_mix_pre, w_in, att_rel_bias, w_dw, b_dw, conv_ln_g, conv_ln_b, g_attn_out, g_conv_out, w_out,
              g_mix_post, g_mem_pre, g_mem_kv, w_mem_q, w_mem_k, w_mem_v, w_mem_o, g_mem_post,
              g_ffn_pre, w_ffn_up, w_ffn_down, g_ffn_post):
    xp, xs = x_prompt, x_sample
    S = xp.shape[1]
    T = xs.shape[1]
    keep_p = min(BAND_PAST, S)
    p_k, p_v, p_c, p_mk, p_mv, s_k, s_v, s_c = [], [], [], [], [], [], [], []
    for l in range(DEPTH):
        q, k, v, u = in_proj(rms_norm(xp, g_mix_pre[l]), w_in[l])
        a = band_attn_prompt(q, k, v, att_rel_bias[l])
        u_ext = jnp.pad(u, ((0, 0), (CONV_WIDTH - 1, 0), (0, 0)))
        c = conv_branch(u_ext, w_dw[l], b_dw[l], conv_ln_g[l], conv_ln_b[l])
        xp = xp + rms_norm(merge_out(a, c, g_attn_out[l], g_conv_out[l], w_out[l]), g_mix_post[l])
        p_k.append(k[:, S - keep_p:])
        p_v.append(v[:, S - keep_p:])
        p_c.append(u[:, S - (CONV_WIDTH - 1):])
        q, k, v, u = in_proj(rms_norm(xs, g_mix_pre[l]), w_in[l])
        k_all = jnp.concatenate([cache_attn_k[l], k], axis=1)
        v_all = jnp.concatenate([cache_attn_v[l], v], axis=1)
        a = band_attn_sample(q, k_all, v_all, att_rel_bias[l])
        u_ext = jnp.concatenate([cache_conv[l], u], axis=1)
        c = conv_branch(u_ext, w_dw[l], b_dw[l], conv_ln_g[l], conv_ln_b[l])
        xs = xs + rms_norm(merge_out(a, c, g_attn_out[l], g_conv_out[l], w_out[l]), g_mix_post[l])
        s_k.append(k_all[:, T:])
        s_v.append(v_all[:, T:])
        s_c.append(u_ext[:, T:])
        mk, mv = mem_kv(mem_prompt, g_mem_kv[l], w_mem_k[l], w_mem_v[l])
        p_mk.append(mk)
        p_mv.append(mv)
        xp = xp + rms_norm(mem_attn(rms_norm(xp, g_mem_pre[l]), mk, mv, w_mem_q[l], w_mem_o[l]), g_mem_post[l])
        xs = xs + rms_norm(mem_attn(rms_norm(xs, g_mem_pre[l]), cache_mem_k[l], cache_mem_v[l],
                                    w_mem_q[l], w_mem_o[l]), g_mem_post[l])
        xp = xp + rms_norm(sq_relu_mlp(rms_norm(xp, g_ffn_pre[l]), w_ffn_up[l], w_ffn_down[l]), g_ffn_post[l])
        xs = xs + rms_norm(sq_relu_mlp(rms_norm(xs, g_ffn_pre[l]), w_ffn_up[l], w_ffn_down[l]), g_ffn_post[l])
    return (xp, xs, jnp.stack(p_k), jnp.stack(p_v), jnp.stack(p_c), jnp.stack(p_mk), jnp.stack(p_mv),
            jnp.stack(s_k), jnp.stack(s_v), jnp.stack(s_c))
```

```cpp
#include <hip/hip_runtime.h>
#include <hip/hip_cooperative_groups.h>
#include <cstdio>
#include <cstdint>
namespace cg = cooperative_groups;
namespace pg8 {
#define PG8_LAS __attribute__((address_space(3)))
typedef unsigned short bf16_t;
typedef short bf16x8 __attribute__((ext_vector_type(8)));
typedef float f32x4 __attribute__((ext_vector_type(4)));
typedef unsigned u32x4 __attribute__((ext_vector_type(4)));
constexpr int BM = 256, BK = 64, HALF = 128, HTB = HALF * BK * 2  , STAGE_BYTES = 8 * HTB, NXCD = 8, WGM = 8;

__host__ __device__ __forceinline__ int lds_byte(int r, int c) { const int st = (r >> 4) * 2 + (c >> 5), rr = r & 15, cc = c & 31, ob = rr * 64 + cc * 2; return st * 1024 + (ob ^ (((ob >> 9) & 1) << 5)); }
__host__ __device__ __forceinline__ void stage_rc(int b, int& R, int& C) { const int st = b / 1024, sb = b % 1024, swz = sb ^ (((sb >> 9) & 1) << 5); R = (st >> 1) * 16 + swz / 64; C = (st & 1) * 32 + (swz % 64) / 2; }
__host__ __device__ __forceinline__ int perm32(int rho) { const int n = rho >> 4, i = rho & 15; return 8 * (i >> 2) + 4 * n + (i & 3); }

struct Unit { int pm, pn; };
struct Gemm { const bf16_t* A; const bf16_t* Bt; int M, N, K; };

struct StaticOrder {
    int nM, nN, nwg, G, c;
    __host__ __device__ void init(int M, int N, int G_, int c_) { nM = M / BM; nN = N / BM; nwg = nM * nN; G = G_; c = c_; }
    __host__ __device__ bool next(int i, Unit& u) const {
        const long L = (long)i * G + c; if (L >= nwg) return false;
        int wgid = (int)L; { const int q = nwg / NXCD, r = nwg % NXCD, xcd = wgid % NXCD, off = wgid / NXCD; wgid = (xcd < r ? xcd * (q + 1) : r * (q + 1) + (xcd - r) * q) + off; }
        const int nig = WGM * nN, gid = wgid / nig, fm = gid * WGM, gsz = (nM - fm) < WGM ? (nM - fm) : WGM;
        u.pm = fm + ((wgid % nig) % gsz); u.pn = (wgid % nig) / gsz; return true;
    }
    __device__ __forceinline__ void a_ready(const Unit&) const {}
    __device__ __forceinline__ void done(const Unit&) const {}
};

__device__ __forceinline__ unsigned cvt_pk_bf16(float lo, float hi) { unsigned r; asm volatile("v_cvt_pk_bf16_f32 %0, %1, %2" : "=v"(r) : "v"(lo), "v"(hi)); return r; }
template <class Epi, class Sched, bool ALIGN_EPI = false, bool SP2 = false>
__device__ __forceinline__ void gemm_phase(PG8_LAS unsigned char* lds, const Gemm g, const Sched& S, const Epi& E) {
    const int tid = threadIdx.x, wid = __builtin_amdgcn_readfirstlane(tid >> 6), lane = tid & 63, wr = wid >> 2, wc = wid & 3, fr = lane & 15, fq = lane >> 4;
    const int K = g.K, nt = K / BK;
    unsigned voffA[2], voffB[2];
#pragma unroll
    for (int i = 0; i < 2; ++i) { int R, C; stage_rc(tid * 16 + i * 8192, R, C); const int Rb = Epi::PERM ? ((R & ~31) + perm32(R & 31)) : R;
        voffA[i] = (unsigned)(R * K + C) * 2u; voffB[i] = (unsigned)(Rb * K + C) * 2u; }
    const size_t kstep = (size_t)(BK * 2);
    const size_t hstep = (size_t)HALF * K * 2;
    const size_t tstep = 2 * hstep;
    const unsigned ldsw = (unsigned)wid * 1024u;
    const int aoff = lds_byte(wr * 64 + fr, fq * 8), boff = lds_byte(wc * 32 + fr, fq * 8);
#define PG8_SA(b, h) (((b) * 2 + (h)) * HTB)
#define PG8_SB(b, h) ((4 + (b) * 2 + (h)) * HTB)
#define PG8_STAGE(bufoff, gbase, voff) do { _Pragma("unroll") for (int _i = 0; _i < 2; ++_i) \
        __builtin_amdgcn_global_load_lds((const unsigned*)((const char*)(gbase) + (voff)[_i]), (PG8_LAS unsigned*)(lds + (bufoff) + ldsw + _i * 8192), 16, 0, 0); } while (0)
#define PG8_LDA(dst, b, h) do { _Pragma("unroll") for (int m = 0; m < 4; ++m) _Pragma("unroll") for (int k = 0; k < 2; ++k) dst[m][k] = *(const PG8_LAS bf16x8*)(lds + PG8_SA(b, h) + aoff + m * 2048 + k * 1024); } while (0)
#define PG8_LDB(dst, b, h) do { _Pragma("unroll") for (int n = 0; n < 2; ++n) _Pragma("unroll") for (int k = 0; k < 2; ++k) dst[n][k] = *(const PG8_LAS bf16x8*)(lds + PG8_SB(b, h) + boff + n * 2048 + k * 1024); } while (0)
#define PG8_MMA(ai, bj, At, Bt) do { __builtin_amdgcn_s_setprio(1); _Pragma("unroll") for (int m = 0; m < 4; ++m) _Pragma("unroll") for (int n = 0; n < 2; ++n) _Pragma("unroll") for (int k = 0; k < 2; ++k) \
        acc[ai][bj][m][n] = __builtin_amdgcn_mfma_f32_16x16x32_bf16(Bt[n][k], At[m][k], acc[ai][bj][m][n], 0, 0, 0); __builtin_amdgcn_s_setprio(0); } while (0)
#define PG8_WAIT_V(n) asm volatile("s_waitcnt vmcnt(" #n ")" ::: "memory")
#define PG8_WAIT_L(n) asm volatile("s_waitcnt lgkmcnt(" #n ")" ::: "memory")
#define PG8_BAR __builtin_amdgcn_s_barrier()
#define PG8_SCHED __builtin_amdgcn_sched_barrier(0)
    Unit cur, nxt; int ui = 0;
    if (!S.next(0, cur)) return;
    f32x4 acc[2][2][4][2];
#pragma unroll
    for (int a = 0; a < 2; ++a)
#pragma unroll
        for (int b = 0; b < 2; ++b)
#pragma unroll
            for (int m = 0; m < 4; ++m)
#pragma unroll
                for (int n = 0; n < 2; ++n) acc[a][b][m][n] = (f32x4){0.f, 0.f, 0.f, 0.f};
    bf16x8 At[4][2], B0[2][2], B1[2][2];
    const char* cA = (const char*)g.A + (size_t)cur.pm * tstep; const char* cB = (const char*)g.Bt + (size_t)cur.pn * tstep;
    S.a_ready(cur);
    if constexpr (SP2) {
        PG8_STAGE(PG8_SB(0, 0), cB, voffB); PG8_STAGE(PG8_SB(0, 1), cB + hstep, voffB); PG8_STAGE(PG8_SA(0, 0), cA, voffA); PG8_STAGE(PG8_SA(0, 1), cA + hstep, voffA);
        if (wr == 1) PG8_BAR;
        PG8_WAIT_V(2); PG8_BAR;
        PG8_STAGE(PG8_SB(1, 0), cB + kstep, voffB); PG8_STAGE(PG8_SA(1, 0), cA + kstep, voffA); PG8_STAGE(PG8_SB(1, 1), cB + hstep + kstep, voffB);
        PG8_WAIT_V(6); PG8_BAR;
    } else {
        PG8_STAGE(PG8_SB(0, 0), cB, voffB); PG8_STAGE(PG8_SA(0, 0), cA, voffA); PG8_STAGE(PG8_SB(0, 1), cB + hstep, voffB); PG8_STAGE(PG8_SA(0, 1), cA + hstep, voffA);
        if (wr == 1) PG8_BAR;
        PG8_WAIT_V(4); PG8_BAR;
        PG8_STAGE(PG8_SB(1, 0), cB + kstep, voffB); PG8_STAGE(PG8_SA(1, 0), cA + kstep, voffA); PG8_STAGE(PG8_SB(1, 1), cB + hstep + kstep, voffB);
        PG8_WAIT_V(6); PG8_BAR;
    }
    for (;;) {
        const bool has_next = S.next(ui + 1, nxt);
        const char* nA = has_next ? (const char*)g.A + (size_t)nxt.pm * tstep : cA; const char* nB = has_next ? (const char*)g.Bt + (size_t)nxt.pn * tstep : cB;
        for (int t = 0; t < nt; t += 2) {
            const bool last = (t == nt - 2);
            const char* a1 = cA + (size_t)(t + 1) * kstep;
            const char* a2 = last ? nA : cA + (size_t)(t + 2) * kstep; const char* b2 = last ? nB : cB + (size_t)(t + 2) * kstep;
            const char* a3 = a2 + kstep; const char* b3 = b2 + kstep;
            if (last && has_next) S.a_ready(nxt);
            if constexpr (SP2) {
            PG8_LDB(B0, 0, 0); PG8_LDB(B1, 0, 1); PG8_SCHED; PG8_LDA(At, 0, 0); PG8_STAGE(PG8_SA(1, 1), a1 + hstep, voffA);
            PG8_WAIT_V(8); PG8_WAIT_L(0); PG8_BAR; PG8_MMA(0, 0, At, B0); PG8_MMA(0, 1, At, B1); PG8_BAR; PG8_SCHED;
            PG8_LDA(At, 0, 1); PG8_STAGE(PG8_SB(0, 0), b2, voffB); PG8_STAGE(PG8_SB(0, 1), b2 + hstep, voffB); PG8_STAGE(PG8_SA(0, 0), a2, voffA);
            PG8_WAIT_V(8); PG8_WAIT_L(0); PG8_BAR; PG8_MMA(1, 0, At, B0); PG8_MMA(1, 1, At, B1); PG8_BAR; PG8_SCHED;
            PG8_LDB(B0, 1, 0); PG8_LDB(B1, 1, 1); PG8_SCHED; PG8_LDA(At, 1, 0); PG8_STAGE(PG8_SA(0, 1), a2 + hstep, voffA);
            PG8_WAIT_V(8); PG8_WAIT_L(0); PG8_BAR; PG8_MMA(0, 0, At, B0); PG8_MMA(0, 1, At, B1); PG8_BAR; PG8_SCHED;
            PG8_LDA(At, 1, 1); PG8_STAGE(PG8_SB(1, 0), b3, voffB); PG8_STAGE(PG8_SB(1, 1), b3 + hstep, voffB); PG8_STAGE(PG8_SA(1, 0), a3, voffA);
            PG8_WAIT_V(8); PG8_WAIT_L(0); PG8_BAR; PG8_MMA(1, 0, At, B0); PG8_MMA(1, 1, At, B1); PG8_BAR; PG8_SCHED;
            } else {
            PG8_LDB(B0, 0, 0); PG8_SCHED; PG8_LDA(At, 0, 0); PG8_STAGE(PG8_SA(1, 1), a1 + hstep, voffA);
            PG8_WAIT_L(8); PG8_BAR; PG8_WAIT_L(0); PG8_MMA(0, 0, At, B0); PG8_BAR; PG8_SCHED;
            PG8_LDB(B1, 0, 1); PG8_STAGE(PG8_SB(0, 0), b2, voffB);
            PG8_BAR; PG8_WAIT_L(0); PG8_MMA(0, 1, At, B1); PG8_BAR;
            PG8_LDA(At, 0, 1); PG8_STAGE(PG8_SA(0, 0), a2, voffA);
            PG8_BAR; PG8_WAIT_L(0); PG8_MMA(1, 0, At, B0); PG8_BAR; PG8_SCHED;
            PG8_STAGE(PG8_SB(0, 1), b2 + hstep, voffB);
            PG8_WAIT_V(6); PG8_BAR; PG8_MMA(1, 1, At, B1); PG8_BAR;
            PG8_LDB(B0, 1, 0); PG8_SCHED; PG8_LDA(At, 1, 0); PG8_STAGE(PG8_SA(0, 1), a2 + hstep, voffA);
            PG8_WAIT_L(8); PG8_BAR; PG8_WAIT_L(0); PG8_MMA(0, 0, At, B0); PG8_BAR; PG8_SCHED;
            PG8_LDB(B1, 1, 1); PG8_STAGE(PG8_SB(1, 0), b3, voffB);
            PG8_BAR; PG8_WAIT_L(0); PG8_MMA(0, 1, At, B1); PG8_BAR;
            PG8_LDA(At, 1, 1); PG8_STAGE(PG8_SA(1, 0), a3, voffA);
            PG8_BAR; PG8_WAIT_L(0); PG8_MMA(1, 0, At, B0); PG8_BAR; PG8_SCHED;
            PG8_STAGE(PG8_SB(1, 1), b3 + hstep, voffB);
            PG8_WAIT_V(6); PG8_BAR; PG8_MMA(1, 1, At, B1); PG8_BAR;
            }
        }
        if constexpr (ALIGN_EPI) { if (wr == 0) PG8_BAR; }
        if constexpr (!Epi::AFTER_DRAIN) { E(acc, cur, wr, wc, fr, fq); S.done(cur); }
        if (!has_next) break;
#pragma unroll
        for (int a = 0; a < 2; ++a)
#pragma unroll
            for (int b = 0; b < 2; ++b)
#pragma unroll
                for (int m = 0; m < 4; ++m)
#pragma unroll
                    for (int n = 0; n < 2; ++n) acc[a][b][m][n] = (f32x4){0.f, 0.f, 0.f, 0.f};
        cur = nxt; cA = nA; cB = nB; ++ui;
        if constexpr (ALIGN_EPI) { if (wr == 1) PG8_BAR; }
    }
    PG8_WAIT_V(0);
    if constexpr (!ALIGN_EPI) { if (wr == 0) PG8_BAR; }
    PG8_BAR;
    if constexpr (Epi::AFTER_DRAIN) { E.fused(acc, cur, wr, wc, fr, fq, lds, wid, lane); S.done(cur); }
#undef PG8_SA
#undef PG8_SB
#undef PG8_STAGE
#undef PG8_LDA
#undef PG8_LDB
#undef PG8_MMA
#undef PG8_WAIT_V
#undef PG8_WAIT_L
#undef PG8_BAR
#undef PG8_SCHED
}
}

#ifndef MK_N_LAUNCHES
#define MK_N_LAUNCHES 1
#endif
#ifndef REPMASK
#define REPMASK 0
#endif
#ifndef REPT
#define REPT 1
#endif
#ifndef REP2A
#define REP2A 1
#endif
#ifndef REP2C
#define REP2C 1
#endif
#ifndef REPCG
#define REPCG 0
#endif
#ifndef REPSYNC
#define REPSYNC 0
#endif
#define LAS __attribute__((address_space(3)))
typedef unsigned short bf16;
typedef LAS unsigned char lds_u8;
typedef float f32x4 __attribute__((ext_vector_type(4)));
typedef float f32x2 __attribute__((ext_vector_type(2)));
typedef float f32x16 __attribute__((ext_vector_type(16)));
typedef short bf16x8 __attribute__((ext_vector_type(8)));
typedef short s16x4 __attribute__((ext_vector_type(4)));
typedef unsigned u32x4 __attribute__((ext_vector_type(4)));
typedef unsigned u32x2 __attribute__((ext_vector_type(2)));
typedef __bf16 bf16x2_t __attribute__((ext_vector_type(2)));

constexpr int NWAVES = 8, NPH = 12;
constexpr int D = 1024, SEQ = 16384, NSAMP = 128, MTOK = SEQ + NSAMP, MP = 16640, NIN = 2560, FF = 4096;
constexpr float EPS = 1e-6f, LOG2E = 1.4426950408889634f;
constexpr float C2A = 0.125f * LOG2E;
constexpr float C2M = 0.0625f * LOG2E;
constexpr int KVSEG = 576;

constexpr size_t O_PK = 16908288, O_PV = 17170432, O_PC = 17432576, O_PMK = 17447936, O_PMV = 17710080, O_SK = 17972224, O_SV = 20069376, O_SC = 22166528;

constexpr size_t MiB = 1u << 20;
constexpr size_t WS_WUP = 1 * MiB, WS_WDN = 9 * MiB, WS_XN = 17 * MiB, WS_Y = 50 * MiB, WS_KB = 50 * MiB, WS_VB = 71 * MiB, WS_PART = 115 * MiB, WS_PARTT = 116 * MiB;
constexpr size_t WS_H = 117 * MiB, WS_WIN = 117 * MiB, WS_WMKV = 122 * MiB, WS_WOUT = 126 * MiB, WS_WQ = 128 * MiB, WS_WO = 130 * MiB, WS_MN = 132 * MiB, WS_MKP = 132 * MiB + 512 * 1024,
                 WS_MVP = 133 * MiB, WS_MKS = 134 * MiB, WS_MVS = 138 * MiB, WS_QB = 142 * MiB, WS_GG = 159 * MiB, WS_MIX = 192 * MiB;
constexpr size_t WS_QM = WS_GG, WS_O2 = WS_MIX;
constexpr size_t WS_XB = 82 * MiB + 512 * 1024;
constexpr size_t WS_END = 248 * MiB;

constexpr int LDS_BYTES = 147456;
constexpr int TABS = 324;
constexpr int L_TAB = 131072, L_WSF = L_TAB + 8 * TABS * 4, L_RED = L_WSF + 8 * 64 * 4, L_RSTD = L_RED + 64 * 8 * 4;
constexpr int L_MISC = L_RSTD + 256;
static_assert(L_MISC + 16 <= LDS_BYTES, "LDS map");

__device__ __forceinline__ unsigned pk2(float lo, float hi) { f32x2 v = {lo, hi}; bf16x2_t b = __builtin_convertvector(v, bf16x2_t); return __builtin_bit_cast(unsigned, b); }
__device__ __forceinline__ float bflo(unsigned p) { return __uint_as_float(p << 16); }
__device__ __forceinline__ float bfhi(unsigned p) { return __uint_as_float(p & 0xffff0000u); }
__device__ __forceinline__ float wave_sum(float v) {
#pragma unroll
    for (int o = 1; o < 64; o <<= 1) v += __shfl_xor(v, o);
    return v;
}
template <int CTRL> __device__ __forceinline__ float dppf(float v) { return __builtin_bit_cast(float, __builtin_amdgcn_update_dpp(0, __builtin_bit_cast(int, v), CTRL, 0xf, 0xf, true)); }
__device__ __forceinline__ float sum32(float v) {
    v += dppf<0xB1>(v);
    v += dppf<0x4E>(v);
    v += dppf<0x141>(v);
    v += dppf<0x140>(v);
    v += __shfl_xor(v, 16);
    return v;
}
__device__ __forceinline__ float rstd_of(float ss, float n) { return 1.0f / sqrtf(ss / n + EPS); }
__device__ __forceinline__ float sigm(float x) { return __builtin_amdgcn_rcpf(1.f + __builtin_amdgcn_exp2f(-LOG2E * x)); }
#define WAITV(n) asm volatile("s_waitcnt vmcnt(" #n ")" ::: "memory")
#define WAITL() asm volatile("s_waitcnt lgkmcnt(0)" ::: "memory")

template <class F> struct EpiRow {
    static constexpr bool PERM = false, AFTER_DRAIN = false;
    F f;
    __device__ __forceinline__ void operator()(const pg8::f32x4 (&acc)[2][2][4][2], const pg8::Unit& u, int wr, int wc, int fr, int fq) const {
#pragma unroll
        for (int ai = 0; ai < 2; ++ai)
#pragma unroll
            for (int m = 0; m < 4; ++m) {
                const int row = u.pm * 256 + ai * 128 + wr * 64 + m * 16 + fr, col0 = u.pn * 256 + wc * 32 + 4 * fq;
                f.row(u, row, col0, acc[ai][0][m][0], acc[ai][0][m][1], acc[ai][1][m][0], acc[ai][1][m][1], wc, fq);
            }
    }
};
template <class F> struct EpiRowP {
    static constexpr bool PERM = true, AFTER_DRAIN = false;
    F f;
    __device__ __forceinline__ void operator()(const pg8::f32x4 (&acc)[2][2][4][2], const pg8::Unit& u, int wr, int wc, int fr, int fq) const {
#pragma unroll
        for (int ai = 0; ai < 2; ++ai)
#pragma unroll
            for (int m = 0; m < 4; ++m) {
                const int row = u.pm * 256 + ai * 128 + wr * 64 + m * 16 + fr, col0 = u.pn * 256 + wc * 32 + 8 * fq;
                f.row8(u, row, col0, acc[ai][0][m][0], acc[ai][0][m][1], acc[ai][1][m][0], acc[ai][1][m][1], wc, fq);
            }
    }
};
__device__ __forceinline__ void st_bf16x8(bf16* p, f32x4 a, f32x4 b) { u32x4 w; w.x = pk2(a.x, a.y); w.y = pk2(a.z, a.w); w.z = pk2(b.x, b.y); w.w = pk2(b.z, b.w); *(u32x4*)p = w; }
__device__ __forceinline__ void st_bf16x4(bf16* p, f32x4 v) { u32x2 w; w.x = pk2(v.x, v.y); w.y = pk2(v.z, v.w); *(u32x2*)p = w; }

struct FInProj {
    bf16 *Qb, *Kb, *Vb, *GG; float* out; const float* rs;
    __device__ __forceinline__ void one(int region, int row, int col, f32x4 v) const {
        if (region == 0) { st_bf16x4(Qb + (size_t)row * 512 + col, v * C2A); }
        else if (region <= 2) {
            const int c = col - 512 * region; bf16* buf = region == 1 ? Kb : Vb;
            const int sr = row - SEQ;
            const int kvrow = row < SEQ ? row : SEQ + (sr >> 4) * KVSEG + 512 + (sr & 15);
            st_bf16x4(buf + (size_t)kvrow * 512 + c, v);
            if (row >= SEQ - 512) {
                float* o = row < SEQ ? out + (region == 1 ? O_PK : O_PV) + (size_t)(row - (SEQ - 512)) * 512 + c
                                     : out + (region == 1 ? O_SK : O_SV) + ((size_t)(sr >> 4) * 512 + 496 + (sr & 15)) * 512 + c;
                *(f32x4*)o = v;
            }
        }
    }
    __device__ __forceinline__ void one8(int region, int row, int col, f32x4 v, f32x4 w) const {
        if (region == 0) { st_bf16x8(Qb + (size_t)row * 512 + col, v * C2A, w * C2A); }
        else {
            const int c = col - 512 * region; bf16* buf = region == 1 ? Kb : Vb;
            const int sr = row - SEQ;
            const int kvrow = row < SEQ ? row : SEQ + (sr >> 4) * KVSEG + 512 + (sr & 15);
            st_bf16x8(buf + (size_t)kvrow * 512 + c, v, w);
            if (row >= SEQ - 512) {
                float* o = row < SEQ ? out + (region == 1 ? O_PK : O_PV) + (size_t)(row - (SEQ - 512)) * 512 + c
                                     : out + (region == 1 ? O_SK : O_SV) + ((size_t)(sr >> 4) * 512 + 496 + (sr & 15)) * 512 + c;
                *(f32x4*)o = v; *(f32x4*)(o + 4) = w;
            }
        }
    }
    __device__ __forceinline__ void glu8(int row, int ch, f32x4 a, f32x4 b, f32x4 g, f32x4 h) const {
        f32x4 u0, u1; u0.x = a.x * sigm(g.x); u0.y = a.y * sigm(g.y); u0.z = a.z * sigm(g.z); u0.w = a.w * sigm(g.w);
        u1.x = b.x * sigm(h.x); u1.y = b.y * sigm(h.y); u1.z = b.z * sigm(h.z); u1.w = b.w * sigm(h.w);
        st_bf16x8(GG + (size_t)row * 512 + ch, u0, u1);
        if (row >= SEQ - 30) { const int sr = row - SEQ;
            float* o = row < SEQ ? out + O_PC + (size_t)(row - (SEQ - 30)) * 512 + ch : out + O_SC + ((size_t)(sr >> 4) * 30 + 14 + (sr & 15)) * 512 + ch;
            *(f32x4*)o = u0; *(f32x4*)(o + 4) = u1; }
    }
    __device__ __forceinline__ void row8(const pg8::Unit& u, int row, int col0, f32x4 a, f32x4 b, f32x4 c, f32x4 d, int, int) const {
        if (row >= MTOK) return;
        { const float r = rs[row]; a = a * r; b = b * r; c = c * r; d = d * r; }
        const int region = u.pn >> 1;
        if (region >= 3) { glu8(row, 128 * (u.pn - 6) + (col0 - 256 * u.pn), a, b, c, d); return; }
        one8(region, row, col0, a, b); one8(region, row, col0 + 128, c, d);
    }
    __device__ __forceinline__ void glu(int row, int ch, f32x4 a, f32x4 g) const {
        f32x4 uv; uv.x = a.x * sigm(g.x); uv.y = a.y * sigm(g.y); uv.z = a.z * sigm(g.z); uv.w = a.w * sigm(g.w);
        st_bf16x4(GG + (size_t)row * 512 + ch, uv);
        if (row >= SEQ - 30) { const int sr = row - SEQ;
            float* o = row < SEQ ? out + O_PC + (size_t)(row - (SEQ - 30)) * 512 + ch : out + O_SC + ((size_t)(sr >> 4) * 30 + 14 + (sr & 15)) * 512 + ch;
            *(f32x4*)o = uv; }
    }
    __device__ __forceinline__ void row(const pg8::Unit& u, int row, int col0, f32x4 a, f32x4 b, f32x4 c, f32x4 d, int, int) const {
        if (row >= MTOK) return;
        const int region = u.pn >> 1;
        if (region >= 3) { const int ch = 128 * (u.pn - 6) + (col0 - 256 * u.pn); glu(row, ch, a, c); glu(row, ch + 16, b, d); return; }
        one(region, row, col0, a); one(region, row, col0 + 16, b); one(region, row, col0 + 128, c); one(region, row, col0 + 144, d);
    }
};
struct FMemKV {
    bf16 *MK, *MV; float* out;
    __device__ __forceinline__ void one(int row, int col, f32x4 v) const {
        if (col < 1024) { *(f32x4*)(out + O_PMK + (size_t)row * 1024 + col) = v; st_bf16x4(MK + (size_t)row * 1024 + col, v); }
        else { *(f32x4*)(out + O_PMV + (size_t)row * 1024 + col - 1024) = v; st_bf16x4(MV + (size_t)row * 1024 + col - 1024, v); }
    }
    __device__ __forceinline__ void row(const pg8::Unit&, int row, int col0, f32x4 a, f32x4 b, f32x4 c, f32x4 d, int, int) const {
        one(row, col0, a); one(row, col0 + 16, b); one(row, col0 + 128, c); one(row, col0 + 144, d);
    }
    __device__ __forceinline__ void row8(const pg8::Unit&, int row, int col0, f32x4 a, f32x4 b, f32x4 c, f32x4 d, int, int) const {
        one(row, col0, a); one(row, col0 + 4, b); one(row, col0 + 128, c); one(row, col0 + 132, d);
    }
};
__device__ __forceinline__ float sq4(f32x4 v) { return (v.x * v.x + v.y * v.y) + (v.z * v.z + v.w * v.w); }
struct FYStat {
    bf16* Y; float *PART, *PARTT;
    __device__ __forceinline__ void row(const pg8::Unit& u, int row, int col0, f32x4 a, f32x4 b, f32x4 c, f32x4 d, int wc, int fq) const {
        bf16* y = Y + (size_t)row * 1024 + col0;
        st_bf16x4(y, a); st_bf16x4(y + 16, b); st_bf16x4(y + 128, c); st_bf16x4(y + 144, d);
        float s = (sq4(a) + sq4(b)) + (sq4(c) + sq4(d));
        s += __shfl_xor(s, 16); s += __shfl_xor(s, 32);
        if (fq == 0) PART[(size_t)row * 16 + u.pn * 4 + wc] = s;
    }
    __device__ __forceinline__ void row8(const pg8::Unit& u, int row, int col0, f32x4 a, f32x4 b, f32x4 c, f32x4 d, int wc, int fq) const {
        bf16* y = Y + (size_t)row * 1024 + col0; st_bf16x8(y, a, b); st_bf16x8(y + 128, c, d);
        float s = (sq4(a) + sq4(b)) + (sq4(c) + sq4(d));
        s += __shfl_xor(s, 16); s += __shfl_xor(s, 32);
        if (fq == 0) PART[(size_t)row * 16 + u.pn * 4 + wc] = s;
    }
    __device__ __forceinline__ void tail(int row, int col, f32x4 v, int tile, int fq) const {
        st_bf16x4(Y + (size_t)row * 1024 + col, v); float s = sq4(v); s += __shfl_xor(s, 16); s += __shfl_xor(s, 32);
        if (fq == 0) PARTT[(size_t)(row - SEQ) * 64 + tile] = s;
    }
};
struct FScaleBf16 {
    bf16* O; int ld; float s0; const float* rs;
    __device__ __forceinline__ void row(const pg8::Unit&, int row, int col0, f32x4 a, f32x4 b, f32x4 c, f32x4 d, int, int) const {
        const float s = s0 * rs[row]; bf16* o = O + (size_t)row * ld + col0; st_bf16x4(o, a * s); st_bf16x4(o + 16, b * s); st_bf16x4(o + 128, c * s); st_bf16x4(o + 144, d * s);
    }
    __device__ __forceinline__ void row8(const pg8::Unit&, int row, int col0, f32x4 a, f32x4 b, f32x4 c, f32x4 d, int, int) const {
        const float s = s0 * rs[row]; bf16* o = O + (size_t)row * ld + col0; st_bf16x8(o, a * s, b * s); st_bf16x8(o + 128, c * s, d * s);
    }
    __device__ __forceinline__ void tail(int row, int col, f32x4 v, int, int) const { st_bf16x4(O + (size_t)row * ld + col, v * (s0 * rs[row])); }
};
__device__ __forceinline__ f32x4 relu2(f32x4 v) { f32x4 r; r.x = fmaxf(v.x, 0.f); r.y = fmaxf(v.y, 0.f); r.z = fmaxf(v.z, 0.f); r.w = fmaxf(v.w, 0.f); return r * r; }
struct FRelu2 {
    bf16* H; const float* rs;
    __device__ __forceinline__ void row(const pg8::Unit&, int row, int col0, f32x4 a, f32x4 b, f32x4 c, f32x4 d, int, int) const {
        const float r = rs[row]; bf16* o = H + (size_t)row * FF + col0; st_bf16x4(o, relu2(a * r)); st_bf16x4(o + 16, relu2(b * r)); st_bf16x4(o + 128, relu2(c * r)); st_bf16x4(o + 144, relu2(d * r));
    }
    __device__ __forceinline__ void row8(const pg8::Unit&, int row, int col0, f32x4 a, f32x4 b, f32x4 c, f32x4 d, int, int) const {
        const float r = rs[row]; bf16* o = H + (size_t)row * FF + col0; st_bf16x8(o, relu2(a * r), relu2(b * r)); st_bf16x8(o + 128, relu2(c * r), relu2(d * r));
    }
    __device__ __forceinline__ void tail(int row, int col, f32x4 v, int, int) const { st_bf16x4(H + (size_t)row * FF + col, relu2(v * rs[row])); }
};
struct OneEach { int first, n, c;
    __device__ __forceinline__ bool next(int i, pg8::Unit& u) const { const int k = c - first; if (i > 0 || k < 0 || k >= n) return false; u.pm = 0; u.pn = k; return true; }
    __device__ __forceinline__ void a_ready(const pg8::Unit&) const {}
    __device__ __forceinline__ void done(const pg8::Unit&) const {}
};

template <int CT, int KB, class F> __device__ __forceinline__ void gemm_tail(lds_u8* lds, const bf16* A, const bf16* Bt, int K, const F& f, int wave, int lane) {
    const int fr = lane & 15, fq = lane >> 4;
    LAS f32x4* red = (LAS f32x4*)lds;
    for (int vv = blockIdx.x; vv < 256 * REPT; vv += gridDim.x) { const int vc = vv & 255;
        const int rt = vc & 7, cb = vc >> 3, ks = K >> 3;
        const bf16* ap = A + (size_t)(SEQ + rt * 16 + fr) * K + wave * ks + fq * 8;
        const bf16* bp = Bt + (size_t)(cb * CT * 16 + fr) * K + wave * ks + fq * 8;
        f32x4 acc[CT];
#pragma unroll
        for (int ct = 0; ct < CT; ++ct) acc[ct] = (f32x4){0.f, 0.f, 0.f, 0.f};
        for (int k0 = 0; k0 < ks; k0 += 32 * KB) {
            bf16x8 a[KB], b[KB][CT];
#pragma unroll
            for (int s = 0; s < KB; ++s) { a[s] = *(const bf16x8*)(ap + k0 + 32 * s);
#pragma unroll
                for (int ct = 0; ct < CT; ++ct) b[s][ct] = *(const bf16x8*)(bp + (size_t)ct * 16 * K + k0 + 32 * s); }
#pragma unroll
            for (int s = 0; s < KB; ++s)
#pragma unroll
                for (int ct = 0; ct < CT; ++ct) acc[ct] = __builtin_amdgcn_mfma_f32_16x16x32_bf16(b[s][ct], a[s], acc[ct], 0, 0, 0);
        }
#pragma unroll
        for (int ct = 0; ct < CT; ++ct) red[(wave * CT + ct) * 64 + lane] = acc[ct];
        __syncthreads();
        for (int ct = wave; ct < CT; ct += 8) {
            f32x4 v = red[ct * 64 + lane];
#pragma unroll
            for (int w = 1; w < 8; ++w) v += red[(w * CT + ct) * 64 + lane];
            f.tail(SEQ + rt * 16 + fr, (cb * CT + ct) * 16 + 4 * fq, v, cb * CT + ct, fq);
        }
        __syncthreads();
    }
}

template <int GLU = 0> __device__ __forceinline__ void p0_transpose_item(const float* W, int K, int N, bf16* WT, int row_off, LAS float* scr, int item, int lane, const float* gs = nullptr) {
    const int nblk = N / 32, kb = item / nblk, nb = item % nblk, k0 = 64 * kb, n0 = 32 * nb;
    int n0w = n0; if (GLU && n0 >= 1536) { const int r = n0 - 1536, isb = r >> 9, rr = r & 511; n0w = 1536 + 256 * (rr >> 7) + 128 * isb + (rr & 127); }
    float wv[32];
#pragma unroll
    for (int i = 0; i < 32; ++i) wv[i] = W[(size_t)(k0 + 2 * i + (lane >> 5)) * N + n0 + (lane & 31)];
    if (gs) {
#pragma unroll
        for (int i = 0; i < 32; ++i) wv[i] *= gs[k0 + 2 * i + (lane >> 5)]; }
#pragma unroll
    for (int i = 0; i < 32; ++i) scr[(2 * i + (lane >> 5)) * 33 + (lane & 31)] = wv[i];
    WAITL();
    const int c = lane & 7;
#pragma unroll
    for (int j = 0; j < 4; ++j) { const int n = (lane >> 3) + 8 * j; const LAS float* s = scr + (8 * c) * 33 + n;
        u32x4 o; o.x = pk2(s[0 * 33], s[1 * 33]); o.y = pk2(s[2 * 33], s[3 * 33]); o.z = pk2(s[4 * 33], s[5 * 33]); o.w = pk2(s[6 * 33], s[7 * 33]);
        *(u32x4*)(WT + (size_t)(row_off + n0w + n) * K + k0 + 8 * c) = o; }
    WAITL();
}
__device__ __forceinline__ void rms_row_to_bf16(const float* xrow, const float* g, bf16* orow, int lane) {
    f32x4 v[4]; float s = 0.f;
#pragma unroll
    for (int j = 0; j < 4; ++j) { v[j] = ((const f32x4*)xrow)[lane + 64 * j]; s += sq4(v[j]); }
    const float rstd = rstd_of(wave_sum(s), 1024.f);
#pragma unroll
    for (int j = 0; j < 4; ++j) { const f32x4 gv = ((const f32x4*)g)[lane + 64 * j]; const f32x4 o = v[j] * rstd * gv; st_bf16x4(orow + 4 * (lane + 64 * j), o); }
}
__device__ __forceinline__ void cvt_row_bf16(const float* src, bf16* dst, int n, int lane) {
    for (int i = lane * 8; i < n; i += 512) { const f32x4 a = *(const f32x4*)(src + i), b = *(const f32x4*)(src + i + 4); u32x4 w; w.x = pk2(a.x, a.y); w.y = pk2(a.z, a.w); w.z = pk2(b.x, b.y); w.w = pk2(b.z, b.w); *(u32x4*)(dst + i) = w; }
}

__device__ __forceinline__ int crow(int r, int hi) { return (r & 3) + 8 * (r >> 2) + 4 * hi; }
__device__ __forceinline__ void glds16(const void* gsrc, unsigned lds_dst) { unsigned keep;
    asm volatile("s_mov_b32 %0, m0\n\ts_mov_b32 m0, %2\n\ts_nop 0\n\tglobal_load_lds_dwordx4 %1, off\n\ts_mov_b32 m0, %0" : "=&s"(keep) : "v"(gsrc), "s"(lds_dst) : "memory"); }
template <int OFF> __device__ __forceinline__ void glds16o(const void* gsrc, unsigned lds_dst) { unsigned keep;
    asm volatile("s_mov_b32 %0, m0\n\ts_mov_b32 m0, %2\n\ts_nop 0\n\tglobal_load_lds_dwordx4 %1, off offset:%c3\n\ts_mov_b32 m0, %0" : "=&s"(keep) : "v"(gsrc), "s"(lds_dst), "i"(OFF) : "memory"); }
template <int OFF> __device__ __forceinline__ void glds16s(const void* sbase, unsigned voff, unsigned lds_dst) { unsigned keep;
    asm volatile("s_mov_b32 %0, m0\n\ts_mov_b32 m0, %3\n\ts_nop 0\n\tglobal_load_lds_dwordx4 %1, %2 offset:%c4\n\ts_mov_b32 m0, %0" : "=&s"(keep) : "v"(voff), "s"(sbase), "s"(lds_dst), "i"(OFF) : "memory"); }
#define RFL(x) ((unsigned)__builtin_amdgcn_readfirstlane((int)(x)))
__device__ __forceinline__ float rowmax32(const f32x16& p0, const f32x16& p1) {
    float a = fmaxf(p0[0], p1[0]);
#pragma unroll
    for (int r = 1; r < 16; ++r) a = fmaxf(a, fmaxf(p0[r], p1[r]));
    auto rr = __builtin_amdgcn_permlane32_swap(__float_as_uint(a), __float_as_uint(a), false, false);
    return fmaxf(__uint_as_float(rr[0]), __uint_as_float(rr[1]));
}
__device__ __forceinline__ float swapsum(float v) { auto rr = __builtin_amdgcn_permlane32_swap(__float_as_uint(v), __float_as_uint(v), false, false); return __uint_as_float(rr[0]) + __uint_as_float(rr[1]); }
typedef short v4i16_t __attribute__((ext_vector_type(4)));
__device__ __forceinline__ s16x4 vtr(const lds_u8* p) { return __builtin_bit_cast(s16x4, __builtin_amdgcn_ds_read_tr16_b64_v4i16((LAS v4i16_t*)p)); }
__device__ __forceinline__ void pv64(f32x16* o, const lds_u8* vp, bf16x8 pa0, bf16x8 pa1, bf16x8 pa2, bf16x8 pa3) {
#pragma unroll
    for (int d0 = 0; d0 < 2; ++d0) { s16x4 lo[4], hi[4];
#pragma unroll
        for (int ks = 0; ks < 4; ++ks) { lo[ks] = vtr(vp + d0 * 64 + ks * 2048); hi[ks] = vtr(vp + d0 * 64 + ks * 2048 + 1024); }
#define PKV(k) (bf16x8){lo[k][0], lo[k][1], lo[k][2], lo[k][3], hi[k][0], hi[k][1], hi[k][2], hi[k][3]}
        o[d0] = __builtin_amdgcn_mfma_f32_32x32x16_bf16(pa0, PKV(0), o[d0], 0, 0, 0);
        o[d0] = __builtin_amdgcn_mfma_f32_32x32x16_bf16(pa1, PKV(1), o[d0], 0, 0, 0);
        o[d0] = __builtin_amdgcn_mfma_f32_32x32x16_bf16(pa2, PKV(2), o[d0], 0, 0, 0);
        o[d0] = __builtin_amdgcn_mfma_f32_32x32x16_bf16(pa3, PKV(3), o[d0], 0, 0, 0);
#undef PKV
    }
}
__device__ __forceinline__ int vb_lane(int lane) { const int hi = lane >> 5; return (4 * hi + ((lane & 15) >> 2)) * 128 + ((((lane >> 4) & 1) ^ ((lane >> 3) & 1)) * 32) + (lane & 3) * 8; }
__device__ __forceinline__ bf16x8 packp(const f32x16& p, int b) { u32x4 w; w.x = pk2(p[b], p[b + 1]); w.y = pk2(p[b + 2], p[b + 3]); w.z = pk2(p[b + 4], p[b + 5]); w.w = pk2(p[b + 6], p[b + 7]); return __builtin_bit_cast(bf16x8, w); }

template <int NQB> __device__ __forceinline__ void band_attn_unit(lds_u8* lds, const bf16* Qb, const bf16* Kb, const bf16* Vb, const float* g_ao, bf16* MIX,
                                                                   int qrow0, int kvrow0, int jstart, bool sample, int nstore, int h, int lane) {
    const int r32 = lane & 31, hi = lane >> 5;
    lds_u8* kslot = lds + h * 16384; lds_u8* vslot = kslot + 8192;
    const unsigned kdst = (unsigned)(uintptr_t)kslot, vdst = (unsigned)(uintptr_t)vslot;
    LAS float* wsf = (LAS float*)(lds + L_WSF) + h * 64;
    const LAS float* tabh = (const LAS float*)(lds + L_TAB) + h * TABS;
    const lds_u8* vb = vslot + vb_lane(lane);
    const unsigned krow = (unsigned)lane >> 3, kslt = (unsigned)lane & 7u;
    const unsigned voffK0 = krow * 1024u + ((kslt ^ (krow >> 1)) << 4), voffK1 = krow * 1024u + ((kslt ^ (4u + (krow >> 1))) << 4);
    const unsigned voffV = krow * 1024u + ((kslt ^ (((krow >> 1) & 1u) << 1)) << 4);
    const unsigned kg_ = ((unsigned)r32 >> 1) & 7u;
    const lds_u8* kad0 = kslot + r32 * 128 + (((0u + hi) ^ kg_) << 4); const lds_u8* kad1 = kslot + r32 * 128 + (((2u + hi) ^ kg_) << 4);
    const lds_u8* kad2 = kslot + r32 * 128 + (((4u + hi) ^ kg_) << 4); const lds_u8* kad3 = kslot + r32 * 128 + (((6u + hi) ^ kg_) << 4);
#define DMA_K(j) do { const bf16* s_ = Kb + ((long)(kvrow0 + 64 * (j)) * 512 + h * 64); \
        _Pragma("unroll") for (int i_ = 0; i_ < 8; ++i_) glds16s<0>(s_ + i_ * 8 * 512, (i_ & 1) ? voffK1 : voffK0, RFL(kdst + i_ * 1024)); } while (0)
#define DMA_V(j) do { const bf16* s_ = Vb + ((long)(kvrow0 + 64 * (j)) * 512 + h * 64); \
        _Pragma("unroll") for (int i_ = 0; i_ < 8; ++i_) glds16s<0>(s_ + i_ * 8 * 512, voffV, RFL(vdst + i_ * 1024)); } while (0)
    f32x16 o[NQB][2]; float lt[NQB];
    bf16x8 qr[NQB][4];
#pragma unroll
    for (int qb = 0; qb < NQB; ++qb)
#pragma unroll
        for (int d0 = 0; d0 < 4; ++d0) qr[qb][d0] = *(const bf16x8*)(Qb + (size_t)(qrow0 + qb * 32 + r32) * 512 + h * 64 + d0 * 16 + hi * 8);
    DMA_K(jstart); DMA_V(jstart);
    float mrow[NQB], lrow[NQB];
#pragma unroll
    for (int qb = 0; qb < NQB; ++qb) { mrow[qb] = -INFINITY; lrow[qb] = 0.f; o[qb][0] = f32x16{}; o[qb][1] = f32x16{}; }
#pragma unroll 1
    for (int j = jstart; j <= 8; ++j) {
        WAITV(8);
        bf16x8 pa[NQB][4];
#pragma unroll
        for (int qb = 0; qb < NQB; ++qb) {
            f32x16 p0, p1;
            if (j <= 5) { const float cb = tabh[256];
#pragma unroll
                for (int r = 0; r < 16; ++r) { p0[r] = cb; p1[r] = cb; } }
            else { const LAS float* tb = tabh + ((8 - j) * 64 + qb * 32 + r32 + 128 - 4 * hi - 59);
#pragma unroll
                for (int r = 0; r < 16; ++r) { p0[r] = tb[59 - ((r & 3) + 8 * (r >> 2))]; p1[r] = tb[27 - ((r & 3) + 8 * (r >> 2))]; } }
            if (sample && j == 8) {
#pragma unroll
                for (int r = 0; r < 16; ++r) { if (r >= 8) p0[r] = -INFINITY; p1[r] = -INFINITY; } }
            {
#pragma unroll
              for (int d0 = 0; d0 < 4; ++d0) { const lds_u8* kb = d0 == 0 ? kad0 : d0 == 1 ? kad1 : d0 == 2 ? kad2 : kad3;
                  const bf16x8 b0 = *(const LAS bf16x8*)kb, b1 = *(const LAS bf16x8*)(kb + 4096);
                  p0 = __builtin_amdgcn_mfma_f32_32x32x16_bf16(b0, qr[qb][d0], p0, 0, 0, 0);
                  p1 = __builtin_amdgcn_mfma_f32_32x32x16_bf16(b1, qr[qb][d0], p1, 0, 0, 0); } }
            if (qb == NQB - 1) { WAITL(); if (j < 8) DMA_K(j + 1); }
            const float rm = rowmax32(p0, p1), mnew = fmaxf(mrow[qb], rm), f = __builtin_amdgcn_exp2f(mrow[qb] - mnew);
            mrow[qb] = mnew; float s = 0.f;
#pragma unroll
            for (int r = 0; r < 16; ++r) { p0[r] = __builtin_amdgcn_exp2f(p0[r] - mnew); p1[r] = __builtin_amdgcn_exp2f(p1[r] - mnew); s += p0[r] + p1[r]; }
            lrow[qb] = lrow[qb] * f + s;
            if (hi == 0) wsf[qb * 32 + r32] = f;
            pa[qb][0] = packp(p0, 0); pa[qb][1] = packp(p0, 8); pa[qb][2] = packp(p1, 0); pa[qb][3] = packp(p1, 8);
        }
        if (j < 8) WAITV(8); else WAITV(0);
#pragma unroll
        for (int qb = 0; qb < NQB; ++qb) {
#pragma unroll
            for (int r = 0; r < 16; ++r) { const float fr_ = wsf[qb * 32 + crow(r, hi)]; o[qb][0][r] *= fr_; o[qb][1][r] *= fr_; }
            pv64(o[qb], vb, pa[qb][0], pa[qb][1], pa[qb][2], pa[qb][3]);
        }
        WAITL();
        if (j < 8) DMA_V(j + 1);
    }
#pragma unroll
    for (int qb = 0; qb < NQB; ++qb) lt[qb] = swapsum(lrow[qb]);
#undef DMA_K
#undef DMA_V
    __syncthreads();
    LAS bf16* st = (LAS bf16*)lds;
    { int sb = hi * 4 * 1024 + (h * 64 + r32) * 2, wb = hi * 16; asm volatile("" : "+v"(sb), "+v"(wb));
      LAS bf16* sp = (LAS bf16*)(lds + sb); const LAS float* wp = (const LAS float*)((lds_u8*)wsf + wb);
#pragma unroll
      for (int qb = 0; qb < NQB; ++qb) {
        if (hi == 0) wsf[r32] = lt[qb];
#pragma unroll
        for (int r = 0; r < 16; ++r) { const int q0 = (r & 3) + 8 * (r >> 2); const float rl = 1.0f / wp[q0];
#pragma unroll
            for (int d0 = 0; d0 < 2; ++d0) sp[(qb * 32 + q0) * 512 + d0 * 32] = (bf16)(pk2(o[qb][d0][r] * rl, 0.f) & 0xffffu); }
        WAITL(); } }
    __syncthreads();
#pragma unroll 1
    for (int rr = 0; rr < 8; ++rr) { const int row = h * 8 + rr;
        if (row < nstore) {
            const u32x4 w = *(const LAS u32x4*)(st + row * 512 + lane * 8);
            float v[8] = {bflo(w.x), bfhi(w.x), bflo(w.y), bfhi(w.y), bflo(w.z), bfhi(w.z), bflo(w.w), bfhi(w.w)};
            float s = 0.f;
#pragma unroll
            for (int i = 0; i < 8; ++i) s += v[i] * v[i];
            const float rs = rstd_of(wave_sum(s), 512.f);
            const f32x4 g0 = *(const f32x4*)(g_ao + lane * 8), g1 = *(const f32x4*)(g_ao + lane * 8 + 4);
            u32x4 ow; ow.x = pk2(v[0] * rs * g0.x, v[1] * rs * g0.y); ow.y = pk2(v[2] * rs * g0.z, v[3] * rs * g0.w); ow.z = pk2(v[4] * rs * g1.x, v[5] * rs * g1.y); ow.w = pk2(v[6] * rs * g1.z, v[7] * rs * g1.w);
            *(u32x4*)(MIX + (size_t)(qrow0 + row) * 1024 + lane * 8) = ow;
        } }
    __syncthreads();
}

struct ConvP { const bf16* GG; const float *cache_conv, *w_dw, *b_dw, *ln_g, *ln_b, *g_co; bf16* MIX; float* out; };
__device__ __forceinline__ void conv_unit(lds_u8* lds, const ConvP& P, int trow0, int nrows, int bs  , bool pconv, int tid) {
    LAS unsigned* U = (LAS unsigned*)lds;
    LAS float* RED = (LAS float*)(lds + L_RED); LAS float* RSTD = (LAS float*)(lds + L_RSTD);
    { const int nit = (30 + nrows) * 128; constexpr int UB = 6;
      for (int it0 = tid; it0 < nit; it0 += 512 * UB) {
        u32x2 ga[UB]; f32x4 cu[UB];
#pragma unroll
        for (int q = 0; q < UB; ++q) { const int it = it0 + q * 512, L = it >> 7, c4 = (it & 127) * 4, t = trow0 - 30 + L;
            ga[q] = (u32x2){0u, 0u}; cu[q] = (f32x4){0.f, 0.f, 0.f, 0.f};
            if (it < nit) {
                if (L < 30 && bs >= 0) cu[q] = *(const f32x4*)(P.cache_conv + ((size_t)bs * 30 + L) * 512 + c4);
                else if (L >= 30 || t >= 0) ga[q] = *(const u32x2*)(P.GG + (size_t)t * 512 + c4); } }
#pragma unroll
        for (int q = 0; q < UB; ++q) { const int it = it0 + q * 512, L = it >> 7, c4 = (it & 127) * 4;
            if (it < nit) { u32x2 w = ga[q];
                if (L < 30 && bs >= 0) { w.x = pk2(cu[q].x, cu[q].y); w.y = pk2(cu[q].z, cu[q].w); }
                *(LAS u32x2*)(U + L * 256 + (c4 >> 1)) = w; } }
      } }
    __syncthreads();
    const int cp = tid & 255, rh = tid >> 8, lane = tid & 63;
    f32x2 w[31];
    unsigned co = (unsigned)cp * 8u; asm volatile("" : "+v"(co));
#pragma unroll
    for (int j = 0; j < 31; ++j) w[j] = *(const f32x2*)((const char*)(P.w_dw + j * 512) + co);
    const f32x2 bdw = *(const f32x2*)((const char*)P.b_dw + co), lng = *(const f32x2*)((const char*)P.ln_g + co), lnb = *(const f32x2*)((const char*)P.ln_b + co), gco = *(const f32x2*)((const char*)P.g_co + co);
#pragma unroll 1
    for (int rb = 0; rb < 8; ++rb) {
        const int i0 = rh * 32 + rb * 4;
        if (i0 < nrows) {
            f32x2 acc[4];
#pragma unroll
            for (int i = 0; i < 4; ++i) acc[i] = bdw;
#pragma unroll
            for (int L = 0; L < 34; ++L) { const unsigned pk = U[(i0 + L) * 256 + cp]; const f32x2 uv = {bflo(pk), bfhi(pk)};
#pragma unroll
                for (int i = 0; i < 4; ++i) { const int j = L - i; if (j >= 0 && j <= 30) acc[i] += w[j] * uv; }
                if ((L & 3) == 3) asm volatile("" ::: "memory"); }
#pragma unroll
            for (int i = 0; i < 4; ++i) {
                const float mu = sum32(acc[i].x + acc[i].y) * (1.f / 64.f);
                const float dx = acc[i].x - mu, dy = acc[i].y - mu;
                const float rs = __builtin_amdgcn_rsqf(sum32(dx * dx + dy * dy) * (1.f / 64.f) + EPS);
                const float yx = dx * rs * lng.x + lnb.x, yy = dy * rs * lng.y + lnb.y;
                const float sx = yx * sigm(yx), sy = yy * sigm(yy);
                const float ss = sum32(sx * sx + sy * sy);
                if ((lane & 31) == 0) RED[(i0 + i) * 8 + (cp >> 5)] = ss;
                *(unsigned*)(P.MIX + (size_t)(trow0 + i0 + i) * 1024 + 512 + 2 * cp) = pk2(sx, sy);
            }
        }
    }
    __syncthreads();
    if (tid < 64 && tid < nrows) { float s = 0.f;
#pragma unroll
        for (int g = 0; g < 8; ++g) s += RED[tid * 8 + g];
        RSTD[tid] = rstd_of(s, 512.f); }
    __syncthreads();
    { unsigned pkv[32]; unsigned* mp0 = (unsigned*)(P.MIX + (size_t)(trow0 + rh * 32) * 1024 + 512 + 2 * cp);
#pragma unroll
      for (int i = 0; i < 32; ++i) pkv[i] = (rh * 32 + i < nrows) ? mp0[(size_t)i * 512] : 0u;
#pragma unroll
      for (int i = 0; i < 32; ++i) if (rh * 32 + i < nrows) { const float r = RSTD[rh * 32 + i]; mp0[(size_t)i * 512] = pk2(bflo(pkv[i]) * r * gco.x, bfhi(pkv[i]) * r * gco.y); } }
    __syncthreads();
}

__device__ __forceinline__ void mem_attn_unit(lds_u8* lds, const bf16* QM, const bf16* MK, const bf16* MV, bf16* O2, int qrow0, int h, int nact, int nstore, int wave, int lane) {
    const int r32 = lane & 31, hi = lane >> 5;
    const unsigned l0 = (unsigned)(uintptr_t)lds;
    LAS float* wsf = (LAS float*)(lds + L_WSF) + wave * 64;
    { const unsigned krow = (unsigned)lane >> 3, kslt = (unsigned)lane & 7u;
      const unsigned vo0 = krow * 2048u + ((kslt ^ (krow >> 1)) << 4), vo1 = krow * 2048u + ((kslt ^ (4u + (krow >> 1))) << 4);
#pragma unroll
      for (int i = 0; i < 16; ++i) { const int pc = wave * 16 + i, cg = pc >> 5, kg8 = pc & 31;
          glds16s<0>(MK + (size_t)(8 * kg8) * 1024 + h * 256 + cg * 64, (i & 1) ? vo1 : vo0, RFL(l0 + cg * 32768 + kg8 * 1024)); } }
    const bool act = wave < nact;
    WAITV(0); __syncthreads();
    f32x16 p[4][2];
    if (act) {
        const bf16* qp = QM + (size_t)(qrow0 + wave * 32 + r32) * 1024 + h * 256 + hi * 8;
#pragma unroll
        for (int half = 0; half < 2; ++half) {
            bf16x8 qr[8];
#pragma unroll
            for (int d = 0; d < 8; ++d) qr[d] = *(const bf16x8*)(qp + (half * 8 + d) * 16);
            const unsigned gk = ((unsigned)r32 >> 1) & 7u;
            unsigned ko0 = (unsigned)(half * 65536 + r32 * 128) + (((0u + hi) ^ gk) << 4), ko1 = (unsigned)(half * 65536 + r32 * 128) + (((2u + hi) ^ gk) << 4),
                     ko2 = (unsigned)(half * 65536 + r32 * 128) + (((4u + hi) ^ gk) << 4), ko3 = (unsigned)(half * 65536 + r32 * 128) + (((6u + hi) ^ gk) << 4);
            asm volatile("" : "+v"(ko0), "+v"(ko1), "+v"(ko2), "+v"(ko3));
#pragma unroll
            for (int kt = 0; kt < 4; ++kt) {
#pragma unroll
                for (int d = 0; d < 8; ++d) { const int d0 = half * 8 + d;
                    const lds_u8* kb = lds + ((d & 3) == 0 ? ko0 : (d & 3) == 1 ? ko1 : (d & 3) == 2 ? ko2 : ko3) + (d >> 2) * 32768 + kt * 8192;
                    const bf16x8 b0 = *(const LAS bf16x8*)kb, b1 = *(const LAS bf16x8*)(kb + 4096);
                    p[kt][0] = __builtin_amdgcn_mfma_f32_32x32x16_bf16(b0, qr[d], d0 == 0 ? f32x16{} : p[kt][0], 0, 0, 0);
                    p[kt][1] = __builtin_amdgcn_mfma_f32_32x32x16_bf16(b1, qr[d], d0 == 0 ? f32x16{} : p[kt][1], 0, 0, 0);
                } }
            __builtin_amdgcn_sched_barrier(0);
        }
    }
    WAITL(); __syncthreads();
    { const unsigned krow = (unsigned)lane >> 3, kslt = (unsigned)lane & 7u, vo = krow * 2048u + ((kslt ^ (((krow >> 1) & 1u) << 1)) << 4);
#pragma unroll
      for (int i = 0; i < 16; ++i) { const int pc = wave * 16 + i, kt = pc >> 5, d64 = (pc >> 3) & 3, kg8 = pc & 7;
          glds16s<0>(MV + (size_t)(kt * 64 + 8 * kg8) * 1024 + h * 256 + d64 * 64, vo, RFL(l0 + (kt * 4 + d64) * 8192 + kg8 * 1024)); } }
    bf16x8 pa[4][4]; float lsum = 0.f;
    if (act) {
        float m = rowmax32(p[0][0], p[0][1]);
#pragma unroll
        for (int kt = 1; kt < 4; ++kt) m = fmaxf(m, rowmax32(p[kt][0], p[kt][1]));
#pragma unroll
        for (int kt = 0; kt < 4; ++kt) {
#pragma unroll
            for (int r = 0; r < 16; ++r) { p[kt][0][r] = __builtin_amdgcn_exp2f(p[kt][0][r] - m); p[kt][1][r] = __builtin_amdgcn_exp2f(p[kt][1][r] - m); lsum += p[kt][0][r] + p[kt][1][r]; }
            pa[kt][0] = packp(p[kt][0], 0); pa[kt][1] = packp(p[kt][0], 8); pa[kt][2] = packp(p[kt][1], 0); pa[kt][3] = packp(p[kt][1], 8);
        }
        lsum = swapsum(lsum);
        if (hi == 0) wsf[r32] = lsum;
    }
    WAITV(0); __syncthreads();
    if (act) {
        float rli[16];
#pragma unroll
        for (int r = 0; r < 16; ++r) rli[r] = 1.0f / wsf[crow(r, hi)];
        const int vb = vb_lane(lane);
#pragma unroll
        for (int dq = 0; dq < 4; ++dq) {
            f32x16 o[2]; o[0] = f32x16{}; o[1] = f32x16{};
            int vbq = vb + dq * 8192; asm volatile("" : "+v"(vbq));
#pragma unroll
            for (int kt = 0; kt < 4; ++kt) pv64(o, lds + vbq + kt * 32768, pa[kt][0], pa[kt][1], pa[kt][2], pa[kt][3]);
            { bf16* ob = O2 + (size_t)(qrow0 + wave * 32) * 1024 + h * 256;
              unsigned lo_ = (unsigned)(4 * hi) * 1024u + (unsigned)r32; asm volatile("" : "+v"(lo_));
#pragma unroll
              for (int r = 0; r < 16; ++r) { const int q0 = (r & 3) + 8 * (r >> 2);
                if (wave * 32 + 4 * hi + q0 < nstore) {
#pragma unroll
                    for (int d0 = 0; d0 < 2; ++d0) ob[lo_ + (unsigned)(q0 * 1024 + dq * 64 + d0 * 32)] = (bf16)(pk2(o[d0][r] * rli[r], 0.f) & 0xffffu); } } }
        }
    }
    WAITL(); __syncthreads();
}

__device__ __forceinline__ f32x4 ld_bf16x4(const bf16* p) { const u32x2 w = *(const u32x2*)p; return (f32x4){bflo(w.x), bfhi(w.x), bflo(w.y), bfhi(w.y)}; }
template <int MODE> __device__ __forceinline__ void thin_phase(const bf16* XN0, float* out, bf16* XB, const bf16* Y, const float* PART, const float* PARTT,
                                                                const float* gpost, float* RS, int gw, int ngw, int lane) {
    for (int row0 = gw; row0 < MTOK; row0 += 2 * ngw) {
        const int rows[2] = {row0, row0 + ngw < MTOK ? row0 + ngw : row0};
        const bool two = row0 + ngw < MTOK;
        float ssp[2]; f32x4 yv[2][4], xv[2][4];
#pragma unroll
        for (int q = 0; q < 2; ++q) { const int row = rows[q];
            ssp[q] = row < SEQ ? PART[(size_t)row * 16 + (lane & 15)] : PARTT[(size_t)(row - SEQ) * 64 + lane];
#pragma unroll
            for (int j = 0; j < 4; ++j) { const int c = 4 * (lane + 64 * j);
                yv[q][j] = ld_bf16x4(Y + (size_t)row * D + c);
                xv[q][j] = ld_bf16x4((MODE == 0 ? XN0 : XB) + (size_t)row * D + c); } }
#pragma unroll
        for (int q = 0; q < 2; ++q) { const int row = rows[q];
            float ss;
            if (row < SEQ) { float s = ssp[q]; s += __shfl_xor(s, 1); s += __shfl_xor(s, 2); s += __shfl_xor(s, 4); s += __shfl_xor(s, 8); ss = s; }
            else ss = wave_sum(ssp[q]);
            const float rs = rstd_of(ss, 1024.f);
            f32x4 v[4]; float s2 = 0.f;
            if (q == 0 || two) {
#pragma unroll
                for (int j = 0; j < 4; ++j) { const int c = 4 * (lane + 64 * j); const f32x4 g = *(const f32x4*)(gpost + c);
                    v[j] = xv[q][j] + yv[q][j] * rs * g; s2 += sq4(v[j]);
                    if (MODE == 2) *(f32x4*)(out + (size_t)row * D + c) = v[j]; else st_bf16x4(XB + (size_t)row * D + c, v[j]); }
                if (MODE != 2) { const float r2 = rstd_of(wave_sum(s2), 1024.f); if (lane == 0) RS[row] = r2; }
            }
        }
    }
}

#define XB_TMO      128
#define XB_XCNT(j)  (256  + 64 * (j))
#define XB_XSUB(j)  (1280 + 64 * (j))
#define XB_XGEN(j)  (2304 + 64 * (j))
#define XB_TOP      3328
#define XB_TOPGEN   3392
#define XCD_BAR_WORDS 3456
#define XB_SPIN_CAP (1u << 18)

__device__ __forceinline__ unsigned xb_ld(unsigned* p)              { return __hip_atomic_load(p, __ATOMIC_RELAXED, __HIP_MEMORY_SCOPE_AGENT); }
__device__ __forceinline__ unsigned xb_add(unsigned* p, unsigned v) { return __hip_atomic_fetch_add(p, v, __ATOMIC_RELAXED, __HIP_MEMORY_SCOPE_AGENT); }
__device__ __forceinline__ unsigned xb_xcc_id() { return (unsigned)__builtin_amdgcn_s_getreg((3 << 11) | 20) & 0xFu; }
#define XB_SPIN(cond, bar) do { unsigned _sp = 0; while (cond) { __builtin_amdgcn_s_sleep(1); \
    if ((++_sp & 255u) == 0u) { if (xb_ld(&(bar)[XB_TMO])) break; if (_sp > XB_SPIN_CAP) { atomicAdd(&(bar)[XB_TMO], 1u); break; } } } } while (0)

struct XcdBarrier {
    unsigned* bar; unsigned x;
    volatile LAS unsigned* st;
};

__device__ __forceinline__ XcdBarrier xcd_barrier_post(unsigned* bar, volatile LAS unsigned* st) {
    XcdBarrier b; b.bar = bar; b.x = xb_xcc_id(); b.st = st;
    if (threadIdx.x == 0) (void)xb_add(&bar[XB_XCNT(b.x)], 1u);
    return b;
}
__device__ __forceinline__ void xcd_barrier_complete(unsigned* bar, unsigned x, unsigned& nloc, unsigned& nx) {
    const unsigned G = gridDim.x * gridDim.y * gridDim.z;
    unsigned sum, cnt, mine, sp = 0u;
    for (;;) {
        sum = 0u; cnt = 0u; mine = 0u;
#pragma unroll
        for (unsigned j = 0; j < 16; ++j) { const unsigned c = xb_ld(&bar[XB_XCNT(j)]); sum += c; cnt += (c > 0u) ? 1u : 0u; mine = (j == x) ? c : mine; }
        if (sum == G) break;
        __builtin_amdgcn_s_sleep(1);
        if ((++sp & 255u) == 0u) { if (xb_ld(&bar[XB_TMO])) break; if (sp > XB_SPIN_CAP) { atomicAdd(&bar[XB_TMO], 1u); break; } }
    }
    nloc = mine > 0u ? mine : 1u; nx = cnt > 0u ? cnt : 1u;
}

__device__ __forceinline__ void xcd_barrier(const XcdBarrier& b) {
    asm volatile("s_waitcnt vmcnt(0)" ::: "memory");
    __syncthreads();
    if (threadIdx.x == 0) {
        unsigned* bar = b.bar;
        __builtin_amdgcn_s_waitcnt(0);
        unsigned nloc = b.st[0], nx = b.st[1];
        if (nloc == 0u) { xcd_barrier_complete(bar, b.x, nloc, nx); b.st[0] = nloc; b.st[1] = nx; }
        const unsigned old = xb_add(&bar[XB_XSUB(b.x)], 1u);
        const unsigned gen = old / nloc;
        if (old + 1u == (gen + 1u) * nloc) {
            __builtin_amdgcn_fence(__ATOMIC_RELEASE, "agent");
            asm volatile("s_waitcnt vmcnt(0)" ::: "memory");
            const unsigned og = xb_add(&bar[XB_TOP], 1u);
            const unsigned tg = og / nx;
            if (og + 1u == (tg + 1u) * nx) xb_add(&bar[XB_TOPGEN], 1u);
            else XB_SPIN(xb_ld(&bar[XB_TOPGEN]) == tg, bar);
            __builtin_amdgcn_fence(__ATOMIC_ACQUIRE, "agent");
            xb_add(&bar[XB_XGEN(b.x)], 1u);
            asm volatile("s_waitcnt vmcnt(0)" ::: "memory");
        } else {
            XB_SPIN(xb_ld(&bar[XB_XGEN(b.x)]) == gen, bar);
            __builtin_amdgcn_fence(__ATOMIC_ACQUIRE, "agent");
            asm volatile("s_waitcnt vmcnt(0)" ::: "memory");
        }
    }
    __syncthreads();
}

struct Args { const float* in[30]; float* out; unsigned char* ws; int ph_lo, ph_hi; };
__global__ void __launch_bounds__(NWAVES * 64, 2) hybrid_fwd(Args args) {
    extern __shared__ __attribute__((aligned(16))) unsigned char lds_raw[];
    lds_u8* lds = (lds_u8*)lds_raw;
    const int tid = threadIdx.x, lane = tid & 63, wave = __builtin_amdgcn_readfirstlane(tid >> 6);
    const int G = gridDim.x, bx = blockIdx.x;
    const int vcu = (G % 8 == 0) ? (bx % 8) * (G / 8) + bx / 8 : bx;
    const int gw = vcu * NWAVES + wave, ngw = G * NWAVES;
#define PHASE_PTRS const __attribute__((address_space(4))) Args* A_ = (const __attribute__((address_space(4))) Args*)__builtin_amdgcn_kernarg_segment_ptr(); asm volatile("" : "+s"(A_)); \
    unsigned char* ws = A_->ws; float* out = A_->out; \
    bf16 *WUP = (bf16*)(ws + WS_WUP), *WDN = (bf16*)(ws + WS_WDN), *XN = (bf16*)(ws + WS_XN), *KB = (bf16*)(ws + WS_KB), *VB = (bf16*)(ws + WS_VB), *HB = (bf16*)(ws + WS_H), \
         *WIN = (bf16*)(ws + WS_WIN), *WMKV = (bf16*)(ws + WS_WMKV), *WOUT = (bf16*)(ws + WS_WOUT), *WQ = (bf16*)(ws + WS_WQ), *WO = (bf16*)(ws + WS_WO), *MN = (bf16*)(ws + WS_MN), \
         *MKP = (bf16*)(ws + WS_MKP), *MVP = (bf16*)(ws + WS_MVP), *MKS = (bf16*)(ws + WS_MKS), *MVS = (bf16*)(ws + WS_MVS), *QB = (bf16*)(ws + WS_QB), *GG = (bf16*)(ws + WS_GG), \
         *MIX = (bf16*)(ws + WS_MIX), *QM = (bf16*)(ws + WS_QM), *O2 = (bf16*)(ws + WS_O2); \
    bf16 *Y = (bf16*)(ws + WS_Y), *XB = (bf16*)(ws + WS_XB); float *PART = (float*)(ws + WS_PART), *PARTT = (float*)(ws + WS_PARTT), *RS = (float*)(ws + WS_PARTT + 65536); (void)XB; (void)RS; \
    (void)WUP; (void)WDN; (void)XN; (void)KB; (void)VB; (void)HB; (void)WIN; (void)WMKV; (void)WOUT; (void)WQ; (void)WO; (void)MN; (void)MKP; (void)MVP; (void)MKS; (void)MVS; (void)QB; (void)GG; (void)MIX; (void)QM; (void)O2; (void)Y; (void)PART; (void)PARTT; (void)out
    const int lo = args.ph_lo, hi_ph = args.ph_hi;
#ifndef REP2
#define REP2 1
#endif
#ifndef REP6
#define REP6 1
#endif
#ifndef PHMASK
#define PHMASK 0xFFF
#endif
#define IN(k) ((((PHMASK) >> (k)) & 1) && lo <= (k) && (k) < hi_ph)
    volatile LAS unsigned* misc = (volatile LAS unsigned*)(lds + L_MISC);
    if (tid < 4) misc[tid] = 0u;
    __syncthreads();
    XcdBarrier bar; bar.bar = (unsigned*)args.ws; bar.x = 0; bar.st = misc;
    if (hi_ph - lo > 1) bar = xcd_barrier_post((unsigned*)args.ws, misc);
    if (hi_ph - lo > 1) cg::this_grid().sync();
    for (int ec_ = 0; ec_ < REPCG; ++ec_) cg::this_grid().sync();
#define SEAM(k) do { if (IN(k) && IN((k) + 1)) { xcd_barrier(bar); } } while (0)

    if (IN(0)) for (int rep_ = 0; rep_ <= (((REPMASK) >> 0) & 1); ++rep_) { PHASE_PTRS;
        LAS float* scr = (LAS float*)(lds + wave * 16384);
        constexpr int I_IN = 16 * 80, I_SQ = 16 * 32;
        constexpr int NIT = I_IN + 2 * I_SQ;
        for (int it = gw; it < NIT; it += ngw) {
            int r = it;
            if (r < I_IN) { p0_transpose_item<1>(A_->in[9], D, NIN, WIN, 0, scr, r, lane, A_->in[8]); continue; } r -= I_IN;
            if (r < I_SQ) { p0_transpose_item(A_->in[22], D, D, WMKV, 0, scr, r, lane); continue; } r -= I_SQ;
            p0_transpose_item(A_->in[23], D, D, WMKV, D, scr, r, lane);
        }
        for (int m = gw; m < MP; m += 2 * ngw) {
            const int m2 = m + ngw;
#pragma unroll
            for (int q = 0; q < 2; ++q) { const int mm = q == 0 ? m : m2;
                if (mm < MP) {
                    if (mm < MTOK) { const float* xr = mm < SEQ ? A_->in[0] + (size_t)mm * D : A_->in[1] + (size_t)(mm - SEQ) * D;
                        f32x4 v[4]; float s0 = 0.f;
#pragma unroll
                        for (int j = 0; j < 4; ++j) { v[j] = ((const f32x4*)xr)[lane + 64 * j]; s0 += sq4(v[j]); }
#pragma unroll
                        for (int j = 0; j < 4; ++j) st_bf16x4(XN + (size_t)mm * D + 4 * (lane + 64 * j), v[j]);
                        const float r0 = rstd_of(wave_sum(s0), 1024.f); if (lane == 0) RS[mm] = r0; }
                    else { u32x4 z = {0u, 0u, 0u, 0u}; ((u32x4*)(XN + (size_t)mm * D))[lane] = z; ((u32x4*)(XN + (size_t)mm * D))[lane + 64] = z; } } }
        }
        for (int m = gw; m < 256; m += ngw) rms_row_to_bf16(A_->in[2] + (size_t)m * D, A_->in[20], MN + (size_t)m * D, lane);
        WAITV(0); __syncthreads();
    }
    SEAM(0);

    if (IN(1)) for (int rep_ = 0; rep_ <= (((REPMASK) >> 1) & 1); ++rep_) { PHASE_PTRS;
        { pg8::Gemm g{XN, WIN, MP, NIN, D}; pg8::StaticOrder S; S.init(MP, NIN, G, bx);
          EpiRowP<FInProj> E{FInProj{QB, KB, VB, GG, out, RS}};
          pg8::gemm_phase<EpiRowP<FInProj>, pg8::StaticOrder, true, true>(lds, g, S, E); }
        { pg8::Gemm g{MN, WMKV, 256, 2048, D}; OneEach S{G >= 8 ? G - 8 : 0, 8, bx};
          EpiRowP<FMemKV> E{FMemKV{MKP, MVP, out}};
          pg8::gemm_phase<EpiRowP<FMemKV>, OneEach, true, true>(lds, g, S, E); }
        { const int first = 650 - 2 * G, last = G - 8, nidle = last - first;
          if (G == 256 ? (bx >= first && bx < last) : true) {
            const int iw = (G == 256 ? (bx - first) : bx) * NWAVES + wave, niw = (G == 256 ? nidle : G) * NWAVES;
            LAS float* scr = (LAS float*)(lds + wave * 16384);
        for (int it = iw; it < 2 * 8 * KVSEG; it += niw) {
            const int kv = it / (8 * KVSEG), rem = it % (8 * KVSEG), b = rem / KVSEG, r = rem % KVSEG;
            bf16* dst = (kv ? VB : KB) + (size_t)(SEQ + b * KVSEG + r) * 512;
            if (r < 512) { const float* src = (kv ? A_->in[4] : A_->in[3]) + ((size_t)b * 512 + r) * 512;
                const f32x4 a = *(const f32x4*)(src + lane * 8), c = *(const f32x4*)(src + lane * 8 + 4);
                u32x4 w; w.x = pk2(a.x, a.y); w.y = pk2(a.z, a.w); w.z = pk2(c.x, c.y); w.w = pk2(c.z, c.w); *(u32x4*)(dst + lane * 8) = w;
                if (r >= 16) { float* o = out + (kv ? O_SV : O_SK) + ((size_t)b * 512 + (r - 16)) * 512 + lane * 8; *(f32x4*)o = a; *(f32x4*)(o + 4) = c; } }
            else if (r >= 528) { u32x4 z = {0u, 0u, 0u, 0u}; *(u32x4*)(dst + lane * 8) = z; }
        }
        for (int it = iw; it < 8 * 14; it += niw) { const int b = it / 14, r = it % 14;
            const float* src = A_->in[5] + ((size_t)b * 30 + 16 + r) * 512; float* o = out + O_SC + ((size_t)b * 30 + r) * 512;
            *(f32x4*)(o + lane * 8) = *(const f32x4*)(src + lane * 8); *(f32x4*)(o + lane * 8 + 4) = *(const f32x4*)(src + lane * 8 + 4); }
        for (int it = iw; it < 2 * 2048; it += niw) { const int kv = it >> 11, r = it & 2047;
            cvt_row_bf16((kv ? A_->in[7] : A_->in[6]) + (size_t)r * 1024, (kv ? MVS : MKS) + (size_t)r * 1024, 1024, lane); }
            constexpr int I_SQ = 16 * 32, NIT2 = 2 * I_SQ;
            for (int it = iw; it < NIT2; it += niw) {
                int r = it;
                if (r < I_SQ) { p0_transpose_item(A_->in[17], D, D, WOUT, 0, scr, r, lane); continue; } r -= I_SQ;
                p0_transpose_item(A_->in[21], D, D, WQ, 0, scr, r, lane, A_->in[19]);
            }
          } }
    }
    SEAM(1);

    if (IN(2)) for (int rep_ = 0; rep_ <= (((REPMASK) >> 2) & 1); ++rep_) { PHASE_PTRS;
        for (int i = tid; i < 8 * TABS; i += NWAVES * 64) { const int hh = i / TABS, k = i % TABS; ((LAS float*)(lds + L_TAB))[i] = A_->in[10][hh * 257 + (k < 256 ? k : 256)] * LOG2E; }
        __syncthreads();
        const ConvP CP{GG, A_->in[5], A_->in[11], A_->in[12], A_->in[13], A_->in[14], A_->in[16], MIX, out};
#ifndef NO_ATTN
        for (int cc = vcu; cc < 256 * REP2A; cc += G) { const int c = cc & 255;
            if (c >= 8) band_attn_unit<2>(lds, QB, KB, VB, A_->in[15], MIX, 64 * c, 64 * c - 512, 0, false, 64, wave, lane);
            else if (c < 4) {
                band_attn_unit<2>(lds, QB, KB, VB, A_->in[15], MIX, 64 * c, 64 * c - 512, 8 - c, false, 64, wave, lane);
                const int c2 = 7 - c;
                band_attn_unit<2>(lds, QB, KB, VB, A_->in[15], MIX, 64 * c2, 64 * c2 - 512, 8 - c2, false, 64, wave, lane);
            } else {
                for (int sb = 2 * (c - 4); sb < 2 * (c - 4) + 2; ++sb) band_attn_unit<1>(lds, QB, KB, VB, A_->in[15], MIX, SEQ + 16 * sb, SEQ + KVSEG * sb, 0, true, 16, wave, lane);
            }
        }
#endif
#ifndef NO_CONV
        for (int cc = vcu; cc < 256 * REP2 * REP2C; cc += G) { const int c = cc & 255;
            conv_unit(lds, CP, 64 * c, 64, -1, c == 255, tid);
            if (c >= 8 && c < 16) conv_unit(lds, CP, SEQ + 16 * (c - 8), 16, c - 8, false, tid);
        }
#endif
    }
    SEAM(2);

    if (IN(3)) for (int rep_ = 0; rep_ <= (((REPMASK) >> 3) & 1); ++rep_) { PHASE_PTRS;
        const FYStat F{Y, PART, PARTT};
        { pg8::Gemm g{MIX, WOUT, SEQ, D, D}; pg8::StaticOrder S; S.init(SEQ, D, G, bx); EpiRowP<FYStat> E{F};
          pg8::gemm_phase<EpiRowP<FYStat>, pg8::StaticOrder, true, true>(lds, g, S, E); }
        gemm_tail<2, 4>(lds, MIX, WOUT, D, F, wave, lane);
    }
    SEAM(3);
    if (IN(4)) for (int rep_ = 0; rep_ <= (((REPMASK) >> 4) & 1); ++rep_) { PHASE_PTRS; thin_phase<0>(XN, out, XB, Y, PART, PARTT, A_->in[18], RS, gw, ngw, lane); }
    SEAM(4);
    for (int es_ = 0; es_ < REPSYNC; ++es_) SEAM(4);
    if (IN(5)) for (int rep_ = 0; rep_ <= (((REPMASK) >> 5) & 1); ++rep_) { PHASE_PTRS;
        const FScaleBf16 F{QM, 1024, C2M, RS};
        { pg8::Gemm g{XB, WQ, SEQ, D, D}; pg8::StaticOrder S; S.init(SEQ, D, G, bx); EpiRowP<FScaleBf16> E{F};
          pg8::gemm_phase<EpiRowP<FScaleBf16>, pg8::StaticOrder, true, true>(lds, g, S, E); }
        gemm_tail<2, 4>(lds, XB, WQ, D, F, wave, lane);
    }
    SEAM(5);
    if (IN(6)) for (int rep_ = 0; rep_ <= (((REPMASK) >> 6) & 1); ++rep_) { PHASE_PTRS;
        for (int uu = bx; uu < (256 + 32) * REP6; uu += G) { const int u = uu % 288;
            if (u < 256) mem_attn_unit(lds, QM, MKP, MVP, O2, (u >> 2) * 256, u & 3, 8, 256, wave, lane);
            else { const int s = u - 256, b = s >> 2; mem_attn_unit(lds, QM, MKS + (size_t)b * 256 * 1024, MVS + (size_t)b * 256 * 1024, O2, SEQ + 16 * b, s & 3, 1, 16, wave, lane); }
        }
        if (G == 256 ? bx >= 32 : true) {
            const int iw = (G == 256 ? bx - 32 : bx) * NWAVES + wave, niw = (G == 256 ? G - 32 : G) * NWAVES;
            LAS float* scr = (LAS float*)(lds + wave * 16384);
            constexpr int I_SQ = 16 * 32, I_UP = 16 * 128, I_DN = 64 * 32, NIT3 = I_SQ + I_UP + I_DN;
            for (int it = iw; it < NIT3; it += niw) {
                int r = it;
                if (r < I_SQ) { p0_transpose_item(A_->in[24], D, D, WO, 0, scr, r, lane); continue; } r -= I_SQ;
                if (r < I_UP) { p0_transpose_item(A_->in[27], D, FF, WUP, 0, scr, r, lane, A_->in[26]); continue; } r -= I_UP;
                p0_transpose_item(A_->in[28], FF, D, WDN, 0, scr, r, lane);
            }
        }
    }
    SEAM(6);
    if (IN(7)) for (int rep_ = 0; rep_ <= (((REPMASK) >> 7) & 1); ++rep_) { PHASE_PTRS;
        const FYStat F{Y, PART, PARTT};
        { pg8::Gemm g{O2, WO, SEQ, D, D}; pg8::StaticOrder S; S.init(SEQ, D, G, bx); EpiRowP<FYStat> E{F};
          pg8::gemm_phase<EpiRowP<FYStat>, pg8::StaticOrder, true, true>(lds, g, S, E); }
        gemm_tail<2, 4>(lds, O2, WO, D, F, wave, lane);
    }
    SEAM(7);
    if (IN(8)) for (int rep_ = 0; rep_ <= (((REPMASK) >> 8) & 1); ++rep_) { PHASE_PTRS; thin_phase<1>(nullptr, out, XB, Y, PART, PARTT, A_->in[25], RS, gw, ngw, lane); }
    SEAM(8);
    if (IN(9)) for (int rep_ = 0; rep_ <= (((REPMASK) >> 9) & 1); ++rep_) { PHASE_PTRS;
        const FRelu2 F{HB, RS};
        { pg8::Gemm g{XB, WUP, SEQ, FF, D}; pg8::StaticOrder S; S.init(SEQ, FF, G, bx); EpiRowP<FRelu2> E{F};
          pg8::gemm_phase<EpiRowP<FRelu2>, pg8::StaticOrder, true, true>(lds, g, S, E); }
        gemm_tail<8, 2>(lds, XB, WUP, D, F, wave, lane);
    }
    SEAM(9);
    if (IN(10)) for (int rep_ = 0; rep_ <= (((REPMASK) >> 10) & 1); ++rep_) { PHASE_PTRS;
        const FYStat F{Y, PART, PARTT};
        { pg8::Gemm g{HB, WDN, SEQ, D, FF}; pg8::StaticOrder S; S.init(SEQ, D, G, bx); EpiRowP<FYStat> E{F};
          pg8::gemm_phase<EpiRowP<FYStat>, pg8::StaticOrder, true, true>(lds, g, S, E); }
        gemm_tail<2, 8>(lds, HB, WDN, FF, F, wave, lane);
    }
    SEAM(10);
    if (IN(11)) for (int rep_ = 0; rep_ <= (((REPMASK) >> 11) & 1); ++rep_) { PHASE_PTRS; thin_phase<2>(nullptr, out, XB, Y, PART, PARTT, A_->in[29], nullptr, gw, ngw, lane); }
#undef IN
#undef SEAM
}

extern "C" void kernel_launch(void* const* d_in, const int* in_sizes, int n_in, void* d_out, int out_size, void* d_ws, size_t ws_size, hipStream_t stream) {
    static int grid = 0;
    if (grid == 0) {
        if (n_in != 30 || ws_size < WS_END) { fprintf(stderr, "kernel_launch: unexpected problem (n_in %d, ws %zu)\n", n_in, ws_size); grid = -1; return; }
        int dev = 0, cus = 0, per_cu = 0;
        (void)hipGetDevice(&dev); (void)hipDeviceGetAttribute(&cus, hipDeviceAttributeMultiprocessorCount, dev);
        (void)hipFuncSetAttribute((const void*)hybrid_fwd, hipFuncAttributeMaxDynamicSharedMemorySize, LDS_BYTES);
        (void)hipOccupancyMaxActiveBlocksPerMultiprocessor(&per_cu, (const void*)hybrid_fwd, NWAVES * 64, LDS_BYTES);
        if (per_cu < 1) { fprintf(stderr, "kernel_launch: occupancy query says %d blocks per CU\n", per_cu); per_cu = 1; }
        (void)hipGetLastError();
        grid = cus * 1;
    }
    if (grid < 0) return;
    Args a{};
    for (int i = 0; i < 30; ++i) a.in[i] = (const float*)d_in[i];
    a.out = (float*)d_out; a.ws = (unsigned char*)d_ws;
#if MK_N_LAUNCHES == 1
    (void)hipMemsetAsync(d_ws, 0, 16384, stream);
    a.ph_lo = 0; a.ph_hi = NPH;
    void* kargs[] = {&a};
    hipError_t e = hipLaunchCooperativeKernel((const void*)hybrid_fwd, dim3(grid), dim3(NWAVES * 64), kargs, LDS_BYTES, stream);
    if (e != hipSuccess) fprintf(stderr, "cooperative launch failed: %s (grid %d)\n", hipGetErrorString(e), grid);
#else
    for (int ph = 0; ph < NPH; ++ph) { a.ph_lo = ph; a.ph_hi = ph + 1; hipLaunchKernelGGL(hybrid_fwd, dim3(grid), dim3(NWAVES * 64), LDS_BYTES, stream, a); }
#endif
}
```

```cpp
#include <hip/hip_runtime.h>
#include <hip/hip_cooperative_groups.h>
#include <cstdio>
#include <cstdint>
namespace cg = cooperative_groups;
namespace pg8 {
#define PG8_LAS __attribute__((address_space(3)))
typedef unsigned short bf16_t;
typedef short bf16x8 __attribute__((ext_vector_type(8)));
typedef float f32x4 __attribute__((ext_vector_type(4)));
typedef unsigned u32x4 __attribute__((ext_vector_type(4)));
constexpr int BM = 256, BK = 64, HALF = 128, HTB = HALF * BK * 2  , STAGE_BYTES = 8 * HTB, NXCD = 8, WGM = 8;

__host__ __device__ __forceinline__ int lds_byte(int r, int c) { const int st = (r >> 4) * 2 + (c >> 5), rr = r & 15, cc = c & 31, ob = rr * 64 + cc * 2; return st * 1024 + (ob ^ (((ob >> 9) & 1) << 5)); }
__host__ __device__ __forceinline__ void stage_rc(int b, int& R, int& C) { const int st = b / 1024, sb = b % 1024, swz = sb ^ (((sb >> 9) & 1) << 5); R = (st >> 1) * 16 + swz / 64; C = (st & 1) * 32 + (swz % 64) / 2; }
__host__ __device__ __forceinline__ int perm32(int rho) { const int n = rho >> 4, i = rho & 15; return 8 * (i >> 2) + 4 * n + (i & 3); }

struct Unit { int pm, pn; };
struct Gemm { const bf16_t* A; const bf16_t* Bt; int M, N, K; };

struct StaticOrder {
    int nM, nN, nwg, G, c;
    __host__ __device__ void init(int M, int N, int G_, int c_) { nM = M / BM; nN = N / BM; nwg = nM * nN; G = G_; c = c_; }
    __host__ __device__ bool next(int i, Unit& u) const {
        const long L = (long)i * G + c; if (L >= nwg) return false;
        int wgid = (int)L; { const int q = nwg / NXCD, r = nwg % NXCD, xcd = wgid % NXCD, off = wgid / NXCD; wgid = (xcd < r ? xcd * (q + 1) : r * (q + 1) + (xcd - r) * q) + off; }
        const int nig = WGM * nN, gid = wgid / nig, fm = gid * WGM, gsz = (nM - fm) < WGM ? (nM - fm) : WGM;
        u.pm = fm + ((wgid % nig) % gsz); u.pn = (wgid % nig) / gsz; return true;
    }
    __device__ __forceinline__ void a_ready(const Unit&) const {}
    __device__ __forceinline__ void done(const Unit&) const {}
};

__device__ __forceinline__ unsigned cvt_pk_bf16(float lo, float hi) { unsigned r; asm volatile("v_cvt_pk_bf16_f32 %0, %1, %2" : "=v"(r) : "v"(lo), "v"(hi)); return r; }
template <class Epi, class Sched, bool ALIGN_EPI = false, bool SP2 = false>
__device__ __forceinline__ void gemm_phase(PG8_LAS unsigned char* lds, const Gemm g, const Sched& S, const Epi& E) {
    const int tid = threadIdx.x, wid = __builtin_amdgcn_readfirstlane(tid >> 6), lane = tid & 63, wr = wid >> 2, wc = wid & 3, fr = lane & 15, fq = lane >> 4;
    const int K = g.K, nt = K / BK;
    unsigned voffA[2], voffB[2];
#pragma unroll
    for (int i = 0; i < 2; ++i) { int R, C; stage_rc(tid * 16 + i * 8192, R, C); const int Rb = Epi::PERM ? ((R & ~31) + perm32(R & 31)) : R;
        voffA[i] = (unsigned)(R * K + C) * 2u; voffB[i] = (unsigned)(Rb * K + C) * 2u; }
    const size_t kstep = (size_t)(BK * 2);
    const size_t hstep = (size_t)HALF * K * 2;
    const size_t tstep = 2 * hstep;
    const unsigned ldsw = (unsigned)wid * 1024u;
    const int aoff = lds_byte(wr * 64 + fr, fq * 8), boff = lds_byte(wc * 32 + fr, fq * 8);
#define PG8_SA(b, h) (((b) * 2 + (h)) * HTB)
#define PG8_SB(b, h) ((4 + (b) * 2 + (h)) * HTB)
#define PG8_STAGE(bufoff, gbase, voff) do { _Pragma("unroll") for (int _i = 0; _i < 2; ++_i) \
        __builtin_amdgcn_global_load_lds((const unsigned*)((const char*)(gbase) + (voff)[_i]), (PG8_LAS unsigned*)(lds + (bufoff) + ldsw + _i * 8192), 16, 0, 0); } while (0)
#define PG8_LDA(dst, b, h) do { _Pragma("unroll") for (int m = 0; m < 4; ++m) _Pragma("unroll") for (int k = 0; k < 2; ++k) dst[m][k] = *(const PG8_LAS bf16x8*)(lds + PG8_SA(b, h) + aoff + m * 2048 + k * 1024); } while (0)
#define PG8_LDB(dst, b, h) do { _Pragma("unroll") for (int n = 0; n < 2; ++n) _Pragma("unroll") for (int k = 0; k < 2; ++k) dst[n][k] = *(const PG8_LAS bf16x8*)(lds + PG8_SB(b, h) + boff + n * 2048 + k * 1024); } while (0)
#define PG8_MMA(ai, bj, At, Bt) do { __builtin_amdgcn_s_setprio(1); _Pragma("unroll") for (int m = 0; m < 4; ++m) _Pragma("unroll") for (int n = 0; n < 2; ++n) _Pragma("unroll") for (int k = 0; k < 2; ++k) \
        acc[ai][bj][m][n] = __builtin_amdgcn_mfma_f32_16x16x32_bf16(Bt[n][k], At[m][k], acc[ai][bj][m][n], 0, 0, 0); __builtin_amdgcn_s_setprio(0); } while (0)
#define PG8_WAIT_V(n) asm volatile("s_waitcnt vmcnt(" #n ")" ::: "memory")
#define PG8_WAIT_L(n) asm volatile("s_waitcnt lgkmcnt(" #n ")" ::: "memory")
#define PG8_BAR __builtin_amdgcn_s_barrier()
#define PG8_SCHED __builtin_amdgcn_sched_barrier(0)
    Unit cur, nxt; int ui = 0;
    if (!S.next(0, cur)) return;
    f32x4 acc[2][2][4][2];
#pragma unroll
    for (int a = 0; a < 2; ++a)
#pragma unroll
        for (int b = 0; b < 2; ++b)
#pragma unroll
            for (int m = 0; m < 4; ++m)
#pragma unroll
                for (int n = 0; n < 2; ++n) acc[a][b][m][n] = (f32x4){0.f, 0.f, 0.f, 0.f};
    bf16x8 At[4][2], B0[2][2], B1[2][2];
    const char* cA = (const char*)g.A + (size_t)cur.pm * tstep; const char* cB = (const char*)g.Bt + (size_t)cur.pn * tstep;
    S.a_ready(cur);
    if constexpr (SP2) {
        PG8_STAGE(PG8_SB(0, 0), cB, voffB); PG8_STAGE(PG8_SB(0, 1), cB + hstep, voffB); PG8_STAGE(PG8_SA(0, 0), cA, voffA); PG8_STAGE(PG8_SA(0, 1), cA + hstep, voffA);
        if (wr == 1) PG8_BAR;
        PG8_WAIT_V(2); PG8_BAR;
        PG8_STAGE(PG8_SB(1, 0), cB + kstep, voffB); PG8_STAGE(PG8_SA(1, 0), cA + kstep, voffA); PG8_STAGE(PG8_SB(1, 1), cB + hstep + kstep, voffB);
        PG8_WAIT_V(6); PG8_BAR;
    } else {
        PG8_STAGE(PG8_SB(0, 0), cB, voffB); PG8_STAGE(PG8_SA(0, 0), cA, voffA); PG8_STAGE(PG8_SB(0, 1), cB + hstep, voffB); PG8_STAGE(PG8_SA(0, 1), cA + hstep, voffA);
        if (wr == 1) PG8_BAR;
        PG8_WAIT_V(4); PG8_BAR;
        PG8_STAGE(PG8_SB(1, 0), cB + kstep, voffB); PG8_STAGE(PG8_SA(1, 0), cA + kstep, voffA); PG8_STAGE(PG8_SB(1, 1), cB + hstep + kstep, voffB);
        PG8_WAIT_V(6); PG8_BAR;
    }
    for (;;) {
        const bool has_next = S.next(ui + 1, nxt);
        const char* nA = has_next ? (const char*)g.A + (size_t)nxt.pm * tstep : cA; const char* nB = has_next ? (const char*)g.Bt + (size_t)nxt.pn * tstep : cB;
        for (int t = 0; t < nt; t += 2) {
            const bool last = (t == nt - 2);
            const char* a1 = cA + (size_t)(t + 1) * kstep;
            const char* a2 = last ? nA : cA + (size_t)(t + 2) * kstep; const char* b2 = last ? nB : cB + (size_t)(t + 2) * kstep;
            const char* a3 = a2 + kstep; const char* b3 = b2 + kstep;
            if (last && has_next) S.a_ready(nxt);
            if constexpr (SP2) {
            PG8_LDB(B0, 0, 0); PG8_LDB(B1, 0, 1); PG8_SCHED; PG8_LDA(At, 0, 0); PG8_STAGE(PG8_SA(1, 1), a1 + hstep, voffA);
            PG8_WAIT_V(8); PG8_WAIT_L(0); PG8_BAR; PG8_MMA(0, 0, At, B0); PG8_MMA(0, 1, At, B1); PG8_BAR; PG8_SCHED;
            PG8_LDA(At, 0, 1); PG8_STAGE(PG8_SB(0, 0), b2, voffB); PG8_STAGE(PG8_SB(0, 1), b2 + hstep, voffB); PG8_STAGE(PG8_SA(0, 0), a2, voffA);
            PG8_WAIT_V(8); PG8_WAIT_L(0); PG8_BAR; PG8_MMA(1, 0, At, B0); PG8_MMA(1, 1, At, B1); PG8_BAR; PG8_SCHED;
            PG8_LDB(B0, 1, 0); PG8_LDB(B1, 1, 1); PG8_SCHED; PG8_LDA(At, 1, 0); PG8_STAGE(PG8_SA(0, 1), a2 + hstep, voffA);
            PG8_WAIT_V(8); PG8_WAIT_L(0); PG8_BAR; PG8_MMA(0, 0, At, B0); PG8_MMA(0, 1, At, B1); PG8_BAR; PG8_SCHED;
            PG8_LDA(At, 1, 1); PG8_STAGE(PG8_SB(1, 0), b3, voffB); PG8_STAGE(PG8_SB(1, 1), b3 + hstep, voffB); PG8_STAGE(PG8_SA(1, 0), a3, voffA);
            PG8_WAIT_V(8); PG8_WAIT_L(0); PG8_BAR; PG8_MMA(1, 0, At, B0); PG8_MMA(1, 1, At, B1); PG8_BAR; PG8_SCHED;
            } else {
            PG8_LDB(B0, 0, 0); PG8_SCHED; PG8_LDA(At, 0, 0); PG8_STAGE(PG8_SA(1, 1), a1 + hstep, voffA);
            PG8_WAIT_L(8); PG8_BAR; PG8_WAIT_L(0); PG8_MMA(0, 0, At, B0); PG8_BAR; PG8_SCHED;
            PG8_LDB(B1, 0, 1); PG8_STAGE(PG8_SB(0, 0), b2, voffB);
            PG8_BAR; PG8_WAIT_L(0); PG8_MMA(0, 1, At, B1); PG8_BAR;
            PG8_LDA(At, 0, 1); PG8_STAGE(PG8_SA(0, 0), a2, voffA);
            PG8_BAR; PG8_WAIT_L(0); PG8_MMA(1, 0, At, B0); PG8_BAR; PG8_SCHED;
            PG8_STAGE(PG8_SB(0, 1), b2 + hstep, voffB);
            PG8_WAIT_V(6); PG8_BAR; PG8_MMA(1, 1, At, B1); PG8_BAR;
            PG8_LDB(B0, 1, 0); PG8_SCHED; PG8_LDA(At, 1, 0); PG8_STAGE(PG8_SA(0, 1), a2 + hstep, voffA);
            PG8_WAIT_L(8); PG8_BAR; PG8_WAIT_L(0); PG8_MMA(0, 0, At, B0); PG8_BAR; PG8_SCHED;
            PG8_LDB(B1, 1, 1); PG8_STAGE(PG8_SB(1, 0), b3, voffB);
            PG8_BAR; PG8_WAIT_L(0); PG8_MMA(0, 1, At, B1); PG8_BAR;
            PG8_LDA(At, 1, 1); PG8_STAGE(PG8_SA(1, 0), a3, voffA);
            PG8_BAR; PG8_WAIT_L(0); PG8_MMA(1, 0, At, B0); PG8_BAR; PG8_SCHED;
            PG8_STAGE(PG8_SB(1, 1), b3 + hstep, voffB);
            PG8_WAIT_V(6); PG8_BAR; PG8_MMA(1, 1, At, B1); PG8_BAR;
            }
        }
        if constexpr (ALIGN_EPI) { if (wr == 0) PG8_BAR; }
        if constexpr (!Epi::AFTER_DRAIN) { E(acc, cur, wr, wc, fr, fq); S.done(cur); }
        if (!has_next) break;
#pragma unroll
        for (int a = 0; a < 2; ++a)
#pragma unroll
            for (int b = 0; b < 2; ++b)
#pragma unroll
                for (int m = 0; m < 4; ++m)
#pragma unroll
                    for (int n = 0; n < 2; ++n) acc[a][b][m][n] = (f32x4){0.f, 0.f, 0.f, 0.f};
        cur = nxt; cA = nA; cB = nB; ++ui;
        if constexpr (ALIGN_EPI) { if (wr == 1) PG8_BAR; }
    }
    PG8_WAIT_V(0);
    if constexpr (!ALIGN_EPI) { if (wr == 0) PG8_BAR; }
    PG8_BAR;
    if constexpr (Epi::AFTER_DRAIN) { E.fused(acc, cur, wr, wc, fr, fq, lds, wid, lane); S.done(cur); }
#undef PG8_SA
#undef PG8_SB
#undef PG8_STAGE
#undef PG8_LDA
#undef PG8_LDB
#undef PG8_MMA
#undef PG8_WAIT_V
#undef PG8_WAIT_L
#undef PG8_BAR
#undef PG8_SCHED
}
}

#ifndef MK_N_LAUNCHES
#define MK_N_LAUNCHES 1
#endif
#ifndef REPMASK
#define REPMASK 0
#endif
#ifndef REPT
#define REPT 1
#endif
#ifndef REP2A
#define REP2A 1
#endif
#ifndef REP2C
#define REP2C 1
#endif
#ifndef REPCG
#define REPCG 0
#endif
#ifndef REPSYNC
#define REPSYNC 0
#endif
#define LAS __attribute__((address_space(3)))
typedef unsigned short bf16;
typedef LAS unsigned char lds_u8;
typedef float f32x4 __attribute__((ext_vector_type(4)));
typedef float f32x2 __attribute__((ext_vector_type(2)));
typedef float f32x16 __attribute__((ext_vector_type(16)));
typedef short bf16x8 __attribute__((ext_vector_type(8)));
typedef short s16x4 __attribute__((ext_vector_type(4)));
typedef unsigned u32x4 __attribute__((ext_vector_type(4)));
typedef unsigned u32x2 __attribute__((ext_vector_type(2)));
typedef __bf16 bf16x2_t __attribute__((ext_vector_type(2)));

constexpr int NWAVES = 8, NPH = 12;
constexpr int D = 1024, SEQ = 16384, NSAMP = 128, MTOK = SEQ + NSAMP, MP = 16640, NIN = 2560, FF = 4096;
constexpr float EPS = 1e-6f, LOG2E = 1.4426950408889634f;
constexpr float C2A = 0.125f * LOG2E;
constexpr float C2M = 0.0625f * LOG2E;
constexpr int KVSEG = 576;

constexpr size_t O_PK = 16908288, O_PV = 17170432, O_PC = 17432576, O_PMK = 17447936, O_PMV = 17710080, O_SK = 17972224, O_SV = 20069376, O_SC = 22166528;

constexpr size_t MiB = 1u << 20;
constexpr size_t WS_WUP = 1 * MiB, WS_WDN = 9 * MiB, WS_XN = 17 * MiB, WS_Y = 50 * MiB, WS_KB = 50 * MiB, WS_VB = 71 * MiB, WS_PART = 115 * MiB, WS_PARTT = 116 * MiB;
constexpr size_t WS_H = 117 * MiB, WS_WIN = 117 * MiB, WS_WMKV = 122 * MiB, WS_WOUT = 126 * MiB, WS_WQ = 128 * MiB, WS_WO = 130 * MiB, WS_MN = 132 * MiB, WS_MKP = 132 * MiB + 512 * 1024,
                 WS_MVP = 133 * MiB, WS_MKS = 134 * MiB, WS_MVS = 138 * MiB, WS_QB = 142 * MiB, WS_GG = 159 * MiB, WS_MIX = 192 * MiB;
constexpr size_t WS_QM = WS_GG, WS_O2 = WS_MIX;
constexpr size_t WS_XB = 82 * MiB + 512 * 1024;
constexpr size_t WS_END = 248 * MiB;

constexpr int LDS_BYTES = 147456;
constexpr int TABS = 324;
constexpr int L_TAB = 131072, L_WSF = L_TAB + 8 * TABS * 4, L_RED = L_WSF + 8 * 64 * 4, L_RSTD = L_RED + 64 * 8 * 4;
constexpr int L_MISC = L_RSTD + 256;
static_assert(L_MISC + 16 <= LDS_BYTES, "LDS map");

__device__ __forceinline__ unsigned pk2(float lo, float hi) { f32x2 v = {lo, hi}; bf16x2_t b = __builtin_convertvector(v, bf16x2_t); return __builtin_bit_cast(unsigned, b); }
__device__ __forceinline__ float bflo(unsigned p) { return __uint_as_float(p << 16); }
__device__ __forceinline__ float bfhi(unsigned p) { return __uint_as_float(p & 0xffff0000u); }
__device__ __forceinline__ float wave_sum(float v) {
#pragma unroll
    for (int o = 1; o < 64; o <<= 1) v += __shfl_xor(v, o);
    return v;
}
template <int CTRL> __device__ __forceinline__ float dppf(float v) { return __builtin_bit_cast(float, __builtin_amdgcn_update_dpp(0, __builtin_bit_cast(int, v), CTRL, 0xf, 0xf, true)); }
__device__ __forceinline__ float sum32(float v) {
    v += dppf<0xB1>(v);
    v += dppf<0x4E>(v);
    v += dppf<0x141>(v);
    v += dppf<0x140>(v);
    v += __shfl_xor(v, 16);
    return v;
}
__device__ __forceinline__ float rstd_of(float ss, float n) { return 1.0f / sqrtf(ss / n + EPS); }
__device__ __forceinline__ float sigm(float x) { return __builtin_amdgcn_rcpf(1.f + __builtin_amdgcn_exp2f(-LOG2E * x)); }
#define WAITV(n) asm volatile("s_waitcnt vmcnt(" #n ")" ::: "memory")
#define WAITL() asm volatile("s_waitcnt lgkmcnt(0)" ::: "memory")

template <class F> struct EpiRow {
    static constexpr bool PERM = false, AFTER_DRAIN = false;
    F f;
    __device__ __forceinline__ void operator()(const pg8::f32x4 (&acc)[2][2][4][2], const pg8::Unit& u, int wr, int wc, int fr, int fq) const {
#pragma unroll
        for (int ai = 0; ai < 2; ++ai)
#pragma unroll
            for (int m = 0; m < 4; ++m) {
                const int row = u.pm * 256 + ai * 128 + wr * 64 + m * 16 + fr, col0 = u.pn * 256 + wc * 32 + 4 * fq;
                f.row(u, row, col0, acc[ai][0][m][0], acc[ai][0][m][1], acc[ai][1][m][0], acc[ai][1][m][1], wc, fq);
            }
    }
};
template <class F> struct EpiRowP {
    static constexpr bool PERM = true, AFTER_DRAIN = false;
    F f;
    __device__ __forceinline__ void operator()(const pg8::f32x4 (&acc)[2][2][4][2], const pg8::Unit& u, int wr, int wc, int fr, int fq) const {
#pragma unroll
        for (int ai = 0; ai < 2; ++ai)
#pragma unroll
            for (int m = 0; m < 4; ++m) {
                const int row = u.pm * 256 + ai * 128 + wr * 64 + m * 16 + fr, col0 = u.pn * 256 + wc * 32 + 8 * fq;
                f.row8(u, row, col0, acc[ai][0][m][0], acc[ai][0][m][1], acc[ai][1][m][0], acc[ai][1][m][1], wc, fq);
            }
    }
};
__device__ __forceinline__ void st_bf16x8(bf16* p, f32x4 a, f32x4 b) { u32x4 w; w.x = pk2(a.x, a.y); w.y = pk2(a.z, a.w); w.z = pk2(b.x, b.y); w.w = pk2(b.z, b.w); *(u32x4*)p = w; }
__device__ __forceinline__ void st_bf16x4(bf16* p, f32x4 v) { u32x2 w; w.x = pk2(v.x, v.y); w.y = pk2(v.z, v.w); *(u32x2*)p = w; }

struct FInProj {
    bf16 *Qb, *Kb, *Vb, *GG; float* out; const float* rs;
    __device__ __forceinline__ void one(int region, int row, int col, f32x4 v) const {
        if (region == 0) { st_bf16x4(Qb + (size_t)row * 512 + col, v * C2A); }
        else if (region <= 2) {
            const int c = col - 512 * region; bf16* buf = region == 1 ? Kb : Vb;
            const int sr = row - SEQ;
            const int kvrow = row < SEQ ? row : SEQ + (sr >> 4) * KVSEG + 512 + (sr & 15);
            st_bf16x4(buf + (size_t)kvrow * 512 + c, v);
            if (row >= SEQ - 512) {
                float* o = row < SEQ ? out + (region == 1 ? O_PK : O_PV) + (size_t)(row - (SEQ - 512)) * 512 + c
                                     : out + (region == 1 ? O_SK : O_SV) + ((size_t)(sr >> 4) * 512 + 496 + (sr & 15)) * 512 + c;
                *(f32x4*)o = v;
            }
        }
    }
    __device__ __forceinline__ void one8(int region, int row, int col, f32x4 v, f32x4 w) const {
        if (region == 0) { st_bf16x8(Qb + (size_t)row * 512 + col, v * C2A, w * C2A); }
        else {
            const int c = col - 512 * region; bf16* buf = region == 1 ? Kb : Vb;
            const int sr = row - SEQ;
            const int kvrow = row < SEQ ? row : SEQ + (sr >> 4) * KVSEG + 512 + (sr & 15);
            st_bf16x8(buf + (size_t)kvrow * 512 + c, v, w);
            if (row >= SEQ - 512) {
                float* o = row < SEQ ? out + (region == 1 ? O_PK : O_PV) + (size_t)(row - (SEQ - 512)) * 512 + c
                                     : out + (region == 1 ? O_SK : O_SV) + ((size_t)(sr >> 4) * 512 + 496 + (sr & 15)) * 512 + c;
                *(f32x4*)o = v; *(f32x4*)(o + 4) = w;
            }
        }
    }
    __device__ __forceinline__ void glu8(int row, int ch, f32x4 a, f32x4 b, f32x4 g, f32x4 h) const {
        f32x4 u0, u1; u0.x = a.x * sigm(g.x); u0.y = a.y * sigm(g.y); u0.z = a.z * sigm(g.z); u0.w = a.w * sigm(g.w);
        u1.x = b.x * sigm(h.x); u1.y = b.y * sigm(h.y); u1.z = b.z * sigm(h.z); u1.w = b.w * sigm(h.w);
        st_bf16x8(GG + (size_t)row * 512 + ch, u0, u1);
        if (row >= SEQ - 30) { const int sr = row - SEQ;
            float* o = row < SEQ ? out + O_PC + (size_t)(row - (SEQ - 30)) * 512 + ch : out + O_SC + ((size_t)(sr >> 4) * 30 + 14 + (sr & 15)) * 512 + ch;
            *(f32x4*)o = u0; *(f32x4*)(o + 4) = u1; }
    }
    __device__ __forceinline__ void row8(const pg8::Unit& u, int row, int col0, f32x4 a, f32x4 b, f32x4 c, f32x4 d, int, int) const {
        if (row >= MTOK) return;
        { const float r = rs[row]; a = a * r; b = b * r; c = c * r; d = d * r; }
        const int region = u.pn >> 1;
        if (region >= 3) { glu8(row, 128 * (u.pn - 6) + (col0 - 256 * u.pn), a, b, c, d); return; }
        one8(region, row, col0, a, b); one8(region, row, col0 + 128, c, d);
    }
    __device__ __forceinline__ void glu(int row, int ch, f32x4 a, f32x4 g) const {
        f32x4 uv; uv.x = a.x * sigm(g.x); uv.y = a.y * sigm(g.y); uv.z = a.z * sigm(g.z); uv.w = a.w * sigm(g.w);
        st_bf16x4(GG + (size_t)row * 512 + ch, uv);
        if (row >= SEQ - 30) { const int sr = row - SEQ;
            float* o = row < SEQ ? out + O_PC + (size_t)(row - (SEQ - 30)) * 512 + ch : out + O_SC + ((size_t)(sr >> 4) * 30 + 14 + (sr & 15)) * 512 + ch;
            *(f32x4*)o = uv; }
    }
    __device__ __forceinline__ void row(const pg8::Unit& u, int row, int col0, f32x4 a, f32x4 b, f32x4 c, f32x4 d, int, int) const {
        if (row >= MTOK) return;
        const int region = u.pn >> 1;
        if (region >= 3) { const int ch = 128 * (u.pn - 6) + (col0 - 256 * u.pn); glu(row, ch, a, c); glu(row, ch + 16, b, d); return; }
        one(region, row, col0, a); one(region, row, col0 + 16, b); one(region, row, col0 + 128, c); one(region, row, col0 + 144, d);
    }
};
struct FMemKV {
    bf16 *MK, *MV; float* out;
    __device__ __forceinline__ void one(int row, int col, f32x4 v) const {
        if (col < 1024) { *(f32x4*)(out + O_PMK + (size_t)row * 1024 + col) = v; st_bf16x4(MK + (size_t)row * 1024 + col, v); }
        else { *(f32x4*)(out + O_PMV + (size_t)row * 1024 + col - 1024) = v; st_bf16x4(MV + (size_t)row * 1024 + col - 1024, v); }
    }
    __device__ __forceinline__ void row(const pg8::Unit&, int row, int col0, f32x4 a, f32x4 b, f32x4 c, f32x4 d, int, int) const {
        one(row, col0, a); one(row, col0 + 16, b); one(row, col0 + 128, c); one(row, col0 + 144, d);
    }
    __device__ __forceinline__ void row8(const pg8::Unit&, int row, int col0, f32x4 a, f32x4 b, f32x4 c, f32x4 d, int, int) const {
        one(row, col0, a); one(row, col0 + 4, b); one(row, col0 + 128, c); one(row, col0 + 132, d);
    }
};
__device__ __forceinline__ float sq4(f32x4 v) { return (v.x * v.x + v.y * v.y) + (v.z * v.z + v.w * v.w); }
struct FYStat {
    bf16* Y; float *PART, *PARTT;
    __device__ __forceinline__ void row(const pg8::Unit& u, int row, int col0, f32x4 a, f32x4 b, f32x4 c, f32x4 d, int wc, int fq) const {
        bf16* y = Y + (size_t)row * 1024 + col0;
        st_bf16x4(y, a); st_bf16x4(y + 16, b); st_bf16x4(y + 128, c); st_bf16x4(y + 144, d);
        float s = (sq4(a) + sq4(b)) + (sq4(c) + sq4(d));
        s += __shfl_xor(s, 16); s += __shfl_xor(s, 32);
        if (fq == 0) PART[(size_t)row * 16 + u.pn * 4 + wc] = s;
    }
    __device__ __forceinline__ void row8(const pg8::Unit& u, int row, int col0, f32x4 a, f32x4 b, f32x4 c, f32x4 d, int wc, int fq) const {
        bf16* y = Y + (size_t)row * 1024 + col0; st_bf16x8(y, a, b); st_bf16x8(y + 128, c, d);
        float s = (sq4(a) + sq4(b)) + (sq4(c) + sq4(d));
        s += __shfl_xor(s, 16); s += __shfl_xor(s, 32);
        if (fq == 0) PART[(size_t)row * 16 + u.pn * 4 + wc] = s;
    }
    __device__ __forceinline__ void tail(int row, int col, f32x4 v, int tile, int fq) const {
        st_bf16x4(Y + (size_t)row * 1024 + col, v); float s = sq4(v); s += __shfl_xor(s, 16); s += __shfl_xor(s, 32);
        if (fq == 0) PARTT[(size_t)(row - SEQ) * 64 + tile] = s;
    }
};
struct FScaleBf16 {
    bf16* O; int ld; float s0; const float* rs;
    __device__ __forceinline__ void row(const pg8::Unit&, int row, int col0, f32x4 a, f32x4 b, f32x4 c, f32x4 d, int, int) const {
        const float s = s0 * rs[row]; bf16* o = O + (size_t)row * ld + col0; st_bf16x4(o, a * s); st_bf16x4(o + 16, b * s); st_bf16x4(o + 128, c * s); st_bf16x4(o + 144, d * s);
    }
    __device__ __forceinline__ void row8(const pg8::Unit&, int row, int col0, f32x4 a, f32x4 b, f32x4 c, f32x4 d, int, int) const {
        const float s = s0 * rs[row]; bf16* o = O + (size_t)row * ld + col0; st_bf16x8(o, a * s, b * s); st_bf16x8(o + 128, c * s, d * s);
    }
    __device__ __forceinline__ void tail(int row, int col, f32x4 v, int, int) const { st_bf16x4(O + (size_t)row * ld + col, v * (s0 * rs[row])); }
};
__device__ __forceinline__ f32x4 relu2(f32x4 v) { f32x4 r; r.x = fmaxf(v.x, 0.f); r.y = fmaxf(v.y, 0.f); r.z = fmaxf(v.z, 0.f); r.w = fmaxf(v.w, 0.f); return r * r; }
struct FRelu2 {
    bf16* H; const float* rs;
    __device__ __forceinline__ void row(const pg8::Unit&, int row, int col0, f32x4 a, f32x4 b, f32x4 c, f32x4 d, int, int) const {
        const float r = rs[row]; bf16* o = H + (size_t)row * FF + col0; st_bf16x4(o, relu2(a * r)); st_bf16x4(o + 16, relu2(b * r)); st_bf16x4(o + 128, relu2(c * r)); st_bf16x4(o + 144, relu2(d * r));
    }
    __device__ __forceinline__ void row8(const pg8::Unit&, int row, int col0, f32x4 a, f32x4 b, f32x4 c, f32x4 d, int, int) const {
        const float r = rs[row]; bf16* o = H + (size_t)row * FF + col0; st_bf16x8(o, relu2(a * r), relu2(b * r)); st_bf16x8(o + 128, relu2(c * r), relu2(d * r));
    }
    __device__ __forceinline__ void tail(int row, int col, f32x4 v, int, int) const { st_bf16x4(H + (size_t)row * FF + col, relu2(v * rs[row])); }
};
struct OneEach { int first, n, c;
    __device__ __forceinline__ bool next(int i, pg8::Unit& u) const { const int k = c - first; if (i > 0 || k < 0 || k >= n) return false; u.pm = 0; u.pn = k; return true; }
    __device__ __forceinline__ void a_ready(const pg8::Unit&) const {}
    __device__ __forceinline__ void done(const pg8::Unit&) const {}
};

template <int CT, int KB, class F> __device__ __forceinline__ void gemm_tail(lds_u8* lds, const bf16* A, const bf16* Bt, int K, const F& f, int wave, int lane) {
    const int fr = lane & 15, fq = lane >> 4;
    LAS f32x4* red = (LAS f32x4*)lds;
    for (int vv = blockIdx.x; vv < 256 * REPT; vv += gridDim.x) { const int vc = vv & 255;
        const int rt = vc & 7, cb = vc >> 3, ks = K >> 3;
        const bf16* ap = A + (size_t)(SEQ + rt * 16 + fr) * K + wave * ks + fq * 8;
        const bf16* bp = Bt + (size_t)(cb * CT * 16 + fr) * K + wave * ks + fq * 8;
        f32x4 acc[CT];
#pragma unroll
        for (int ct = 0; ct < CT; ++ct) acc[ct] = (f32x4){0.f, 0.f, 0.f, 0.f};
        for (int k0 = 0; k0 < ks; k0 += 32 * KB) {
            bf16x8 a[KB], b[KB][CT];
#pragma unroll
            for (int s = 0; s < KB; ++s) { a[s] = *(const bf16x8*)(ap + k0 + 32 * s);
#pragma unroll
                for (int ct = 0; ct < CT; ++ct) b[s][ct] = *(const bf16x8*)(bp + (size_t)ct * 16 * K + k0 + 32 * s); }
#pragma unroll
            for (int s = 0; s < KB; ++s)
#pragma unroll
                for (int ct = 0; ct < CT; ++ct) acc[ct] = __builtin_amdgcn_mfma_f32_16x16x32_bf16(b[s][ct], a[s], acc[ct], 0, 0, 0);
        }
#pragma unroll
        for (int ct = 0; ct < CT; ++ct) red[(wave * CT + ct) * 64 + lane] = acc[ct];
        __syncthreads();
        for (int ct = wave; ct < CT; ct += 8) {
            f32x4 v = red[ct * 64 + lane];
#pragma unroll
            for (int w = 1; w < 8; ++w) v += red[(w * CT + ct) * 64 + lane];
            f.tail(SEQ + rt * 16 + fr, (cb * CT + ct) * 16 + 4 * fq, v, cb * CT + ct, fq);
        }
        __syncthreads();
    }
}

template <int GLU = 0> __device__ __forceinline__ void p0_transpose_item(const float* W, int K, int N, bf16* WT, int row_off, LAS float* scr, int item, int lane, const float* gs = nullptr) {
    const int nblk = N / 32, kb = item / nblk, nb = item % nblk, k0 = 64 * kb, n0 = 32 * nb;
    int n0w = n0; if (GLU && n0 >= 1536) { const int r = n0 - 1536, isb = r >> 9, rr = r & 511; n0w = 1536 + 256 * (rr >> 7) + 128 * isb + (rr & 127); }
    float wv[32];
#pragma unroll
    for (int i = 0; i < 32; ++i) wv[i] = W[(size_t)(k0 + 2 * i + (lane >> 5)) * N + n0 + (lane & 31)];
    if (gs) {
#pragma unroll
        for (int i = 0; i < 32; ++i) wv[i] *= gs[k0 + 2 * i + (lane >> 5)]; }
#pragma unroll
    for (int i = 0; i < 32; ++i) scr[(2 * i + (lane >> 5)) * 33 + (lane & 31)] = wv[i];
    WAITL();
    const int c = lane & 7;
#pragma unroll
    for (int j = 0; j < 4; ++j) { const int n = (lane >> 3) + 8 * j; const LAS float* s = scr + (8 * c) * 33 + n;
        u32x4 o; o.x = pk2(s[0 * 33], s[1 * 33]); o.y = pk2(s[2 * 33], s[3 * 33]); o.z = pk2(s[4 * 33], s[5 * 33]); o.w = pk2(s[6 * 33], s[7 * 33]);
        *(u32x4*)(WT + (size_t)(row_off + n0w + n) * K + k0 + 8 * c) = o; }
    WAITL();
}
__device__ __forceinline__ void rms_row_to_bf16(const float* xrow, const float* g, bf16* orow, int lane) {
    f32x4 v[4]; float s = 0.f;
#pragma unroll
    for (int j = 0; j < 4; ++j) { v[j] = ((const f32x4*)xrow)[lane + 64 * j]; s += sq4(v[j]); }
    const float rstd = rstd_of(wave_sum(s), 1024.f);
#pragma unroll
    for (int j = 0; j < 4; ++j) { const f32x4 gv = ((const f32x4*)g)[lane + 64 * j]; const f32x4 o = v[j] * rstd * gv; st_bf16x4(orow + 4 * (lane + 64 * j), o); }
}
__device__ __forceinline__ void cvt_row_bf16(const float* src, bf16* dst, int n, int lane) {
    for (int i = lane * 8; i < n; i += 512) { const f32x4 a = *(const f32x4*)(src + i), b = *(const f32x4*)(src + i + 4); u32x4 w; w.x = pk2(a.x, a.y); w.y = pk2(a.z, a.w); w.z = pk2(b.x, b.y); w.w = pk2(b.z, b.w); *(u32x4*)(dst + i) = w; }
}

__device__ __forceinline__ int crow(int r, int hi) { return (r & 3) + 8 * (r >> 2) + 4 * hi; }
__device__ __forceinline__ void glds16(const void* gsrc, unsigned lds_dst) { unsigned keep;
    asm volatile("s_mov_b32 %0, m0\n\ts_mov_b32 m0, %2\n\ts_nop 0\n\tglobal_load_lds_dwordx4 %1, off\n\ts_mov_b32 m0, %0" : "=&s"(keep) : "v"(gsrc), "s"(lds_dst) : "memory"); }
template <int OFF> __device__ __forceinline__ void glds16o(const void* gsrc, unsigned lds_dst) { unsigned keep;
    asm volatile("s_mov_b32 %0, m0\n\ts_mov_b32 m0, %2\n\ts_nop 0\n\tglobal_load_lds_dwordx4 %1, off offset:%c3\n\ts_mov_b32 m0, %0" : "=&s"(keep) : "v"(gsrc), "s"(lds_dst), "i"(OFF) : "memory"); }
template <int OFF> __device__ __forceinline__ void glds16s(const void* sbase, unsigned voff, unsigned lds_dst) { unsigned keep;
    asm volatile("s_mov_b32 %0, m0\n\ts_mov_b32 m0, %3\n\ts_nop 0\n\tglobal_load_lds_dwordx4 %1, %2 offset:%c4\n\ts_mov_b32 m0, %0" : "=&s"(keep) : "v"(voff), "s"(sbase), "s"(lds_dst), "i"(OFF) : "memory"); }
#define RFL(x) ((unsigned)__builtin_amdgcn_readfirstlane((int)(x)))
__device__ __forceinline__ float rowmax32(const f32x16& p0, const f32x16& p1) {
    float a = fmaxf(p0[0], p1[0]);
#pragma unroll
    for (int r = 1; r < 16; ++r) a = fmaxf(a, fmaxf(p0[r], p1[r]));
    auto rr = __builtin_amdgcn_permlane32_swap(__float_as_uint(a), __float_as_uint(a), false, false);
    return fmaxf(__uint_as_float(rr[0]), __uint_as_float(rr[1]));
}
__device__ __forceinline__ float swapsum(float v) { auto rr = __builtin_amdgcn_permlane32_swap(__float_as_uint(v), __float_as_uint(v), false, false); return __uint_as_float(rr[0]) + __uint_as_float(rr[1]); }
typedef short v4i16_t __attribute__((ext_vector_type(4)));
__device__ __forceinline__ s16x4 vtr(const lds_u8* p) { return __builtin_bit_cast(s16x4, __builtin_amdgcn_ds_read_tr16_b64_v4i16((LAS v4i16_t*)p)); }
__device__ __forceinline__ void pv64(f32x16* o, const lds_u8* vp, bf16x8 pa0, bf16x8 pa1, bf16x8 pa2, bf16x8 pa3) {
#pragma unroll
    for (int d0 = 0; d0 < 2; ++d0) { s16x4 lo[4], hi[4];
#pragma unroll
        for (int ks = 0; ks < 4; ++ks) { lo[ks] = vtr(vp + d0 * 64 + ks * 2048); hi[ks] = vtr(vp + d0 * 64 + ks * 2048 + 1024); }
#define PKV(k) (bf16x8){lo[k][0], lo[k][1], lo[k][2], lo[k][3], hi[k][0], hi[k][1], hi[k][2], hi[k][3]}
        o[d0] = __builtin_amdgcn_mfma_f32_32x32x16_bf16(pa0, PKV(0), o[d0], 0, 0, 0);
        o[d0] = __builtin_amdgcn_mfma_f32_32x32x16_bf16(pa1, PKV(1), o[d0], 0, 0, 0);
        o[d0] = __builtin_amdgcn_mfma_f32_32x32x16_bf16(pa2, PKV(2), o[d0], 0, 0, 0);
        o[d0] = __builtin_amdgcn_mfma_f32_32x32x16_bf16(pa3, PKV(3), o[d0], 0, 0, 0);
#undef PKV
    }
}
__device__ __forceinline__ int vb_lane(int lane) { const int hi = lane >> 5; return (4 * hi + ((lane & 15) >> 2)) * 128 + ((((lane >> 4) & 1) ^ ((lane >> 3) & 1)) * 32) + (lane & 3) * 8; }
__device__ __forceinline__ bf16x8 packp(const f32x16& p, int b) { u32x4 w; w.x = pk2(p[b], p[b + 1]); w.y = pk2(p[b + 2], p[b + 3]); w.z = pk2(p[b + 4], p[b + 5]); w.w = pk2(p[b + 6], p[b + 7]); return __builtin_bit_cast(bf16x8, w); }

template <int NQB> __device__ __forceinline__ void band_attn_unit(lds_u8* lds, const bf16* Qb, const bf16* Kb, const bf16* Vb, const float* g_ao, bf16* MIX,
                                                                   int qrow0, int kvrow0, int jstart, bool sample, int nstore, int h, int lane) {
    const int r32 = lane & 31, hi = lane >> 5;
    lds_u8* kslot = lds + h * 16384; lds_u8* vslot = kslot + 8192;
    const unsigned kdst = (unsigned)(uintptr_t)kslot, vdst = (unsigned)(uintptr_t)vslot;
    LAS float* wsf = (LAS float*)(lds + L_WSF) + h * 64;
    const LAS float* tabh = (const LAS float*)(lds + L_TAB) + h * TABS;
    const lds_u8* vb = vslot + vb_lane(lane);
    const unsigned krow = (unsigned)lane >> 3, kslt = (unsigned)lane & 7u;
    const unsigned voffK0 = krow * 1024u + ((kslt ^ (krow >> 1)) << 4), voffK1 = krow * 1024u + ((kslt ^ (4u + (krow >> 1))) << 4);
    const unsigned voffV = krow * 1024u + ((kslt ^ (((krow >> 1) & 1u) << 1)) << 4);
    const unsigned kg_ = ((unsigned)r32 >> 1) & 7u;
    const lds_u8* kad0 = kslot + r32 * 128 + (((0u + hi) ^ kg_) << 4); const lds_u8* kad1 = kslot + r32 * 128 + (((2u + hi) ^ kg_) << 4);
    const lds_u8* kad2 = kslot + r32 * 128 + (((4u + hi) ^ kg_) << 4); const lds_u8* kad3 = kslot + r32 * 128 + (((6u + hi) ^ kg_) << 4);
#define DMA_K(j) do { const bf16* s_ = Kb + ((long)(kvrow0 + 64 * (j)) * 512 + h * 64); \
        _Pragma("unroll") for (int i_ = 0; i_ < 8; ++i_) glds16s<0>(s_ + i_ * 8 * 512, (i_ & 1) ? voffK1 : voffK0, RFL(kdst + i_ * 1024)); } while (0)
#define DMA_V(j) do { const bf16* s_ = Vb + ((long)(kvrow0 + 64 * (j)) * 512 + h * 64); \
        _Pragma("unroll") for (int i_ = 0; i_ < 8; ++i_) glds16s<0>(s_ + i_ * 8 * 512, voffV, RFL(vdst + i_ * 1024)); } while (0)
    f32x16 o[NQB][2]; float lt[NQB];
    bf16x8 qr[NQB][4];
#pragma unroll
    for (int qb = 0; qb < NQB; ++qb)
#pragma unroll
        for (int d0 = 0; d0 < 4; ++d0) qr[qb][d0] = *(const bf16x8*)(Qb + (size_t)(qrow0 + qb * 32 + r32) * 512 + h * 64 + d0 * 16 + hi * 8);
    DMA_K(jstart); DMA_V(jstart);
    float mrow[NQB], lrow[NQB];
#pragma unroll
    for (int qb = 0; qb < NQB; ++qb) { mrow[qb] = -INFINITY; lrow[qb] = 0.f; o[qb][0] = f32x16{}; o[qb][1] = f32x16{}; }
#pragma unroll 1
    for (int j = jstart; j <= 8; ++j) {
        WAITV(8);
        bf16x8 pa[NQB][4];
#pragma unroll
        for (int qb = 0; qb < NQB; ++qb) {
            f32x16 p0, p1;
            if (j <= 5) { const float cb = tabh[256];
#pragma unroll
                for (int r = 0; r < 16; ++r) { p0[r] = cb; p1[r] = cb; } }
            else { const LAS float* tb = tabh + ((8 - j) * 64 + qb * 32 + r32 + 128 - 4 * hi - 59);
#pragma unroll
                for (int r = 0; r < 16; ++r) { p0[r] = tb[59 - ((r & 3) + 8 * (r >> 2))]; p1[r] = tb[27 - ((r & 3) + 8 * (r >> 2))]; } }
            if (sample && j == 8) {
#pragma unroll
                for (int r = 0; r < 16; ++r) { if (r >= 8) p0[r] = -INFINITY; p1[r] = -INFINITY; } }
            {
#pragma unroll
              for (int d0 = 0; d0 < 4; ++d0) { const lds_u8* kb = d0 == 0 ? kad0 : d0 == 1 ? kad1 : d0 == 2 ? kad2 : kad3;
                  const bf16x8 b0 = *(const LAS bf16x8*)kb, b1 = *(const LAS bf16x8*)(kb + 4096);
                  p0 = __builtin_amdgcn_mfma_f32_32x32x16_bf16(b0, qr[qb][d0], p0, 0, 0, 0);
                  p1 = __builtin_amdgcn_mfma_f32_32x32x16_bf16(b1, qr[qb][d0], p1, 0, 0, 0); } }
            if (qb == NQB - 1) { WAITL(); if (j < 8) DMA_K(j + 1); }
            const float rm = rowmax32(p0, p1), mnew = fmaxf(mrow[qb], rm), f = __builtin_amdgcn_exp2f(mrow[qb] - mnew);
            mrow[qb] = mnew; float s = 0.f;
#pragma unroll
            for (int r = 0; r < 16; ++r) { p0[r] = __builtin_amdgcn_exp2f(p0[r] - mnew); p1[r] = __builtin_amdgcn_exp2f(p1[r] - mnew); s += p0[r] + p1[r]; }
            lrow[qb] = lrow[qb] * f + s;
            if (hi == 0) wsf[qb * 32 + r32] = f;
            pa[qb][0] = packp(p0, 0); pa[qb][1] = packp(p0, 8); pa[qb][2] = packp(p1, 0); pa[qb][3] = packp(p1, 8);
        }
        if (j < 8) WAITV(8); else WAITV(0);
#pragma unroll
        for (int qb = 0; qb < NQB; ++qb) {
#pragma unroll
            for (int r = 0; r < 16; ++r) { const float fr_ = wsf[qb * 32 + crow(r, hi)]; o[qb][0][r] *= fr_; o[qb][1][r] *= fr_; }
            pv64(o[qb], vb, pa[qb][0], pa[qb][1], pa[qb][2], pa[qb][3]);
        }
        WAITL();
        if (j < 8) DMA_V(j + 1);
    }
#pragma unroll
    for (int qb = 0; qb < NQB; ++qb) lt[qb] = swapsum(lrow[qb]);
#undef DMA_K
#undef DMA_V
    __syncthreads();
    LAS bf16* st = (LAS bf16*)lds;
    { int sb = hi * 4 * 1024 + (h * 64 + r32) * 2, wb = hi * 16; asm volatile("" : "+v"(sb), "+v"(wb));
      LAS bf16* sp = (LAS bf16*)(lds + sb); const LAS float* wp = (const LAS float*)((lds_u8*)wsf + wb);
#pragma unroll
      for (int qb = 0; qb < NQB; ++qb) {
        if (hi == 0) wsf[r32] = lt[qb];
#pragma unroll
        for (int r = 0; r < 16; ++r) { const int q0 = (r & 3) + 8 * (r >> 2); const float rl = 1.0f / wp[q0];
#pragma unroll
            for (int d0 = 0; d0 < 2; ++d0) sp[(qb * 32 + q0) * 512 + d0 * 32] = (bf16)(pk2(o[qb][d0][r] * rl, 0.f) & 0xffffu); }
        WAITL(); } }
    __syncthreads();
#pragma unroll 1
    for (int rr = 0; rr < 8; ++rr) { const int row = h * 8 + rr;
        if (row < nstore) {
            const u32x4 w = *(const LAS u32x4*)(st + row * 512 + lane * 8);
            float v[8] = {bflo(w.x), bfhi(w.x), bflo(w.y), bfhi(w.y), bflo(w.z), bfhi(w.z), bflo(w.w), bfhi(w.w)};
            float s = 0.f;
#pragma unroll
            for (int i = 0; i < 8; ++i) s += v[i] * v[i];
            const float rs = rstd_of(wave_sum(s), 512.f);
            const f32x4 g0 = *(const f32x4*)(g_ao + lane * 8), g1 = *(const f32x4*)(g_ao + lane * 8 + 4);
            u32x4 ow; ow.x = pk2(v[0] * rs * g0.x, v[1] * rs * g0.y); ow.y = pk2(v[2] * rs * g0.z, v[3] * rs * g0.w); ow.z = pk2(v[4] * rs * g1.x, v[5] * rs * g1.y); ow.w = pk2(v[6] * rs * g1.z, v[7] * rs * g1.w);
            *(u32x4*)(MIX + (size_t)(qrow0 + row) * 1024 + lane * 8) = ow;
        } }
    __syncthreads();
}

struct ConvP { const bf16* GG; const float *cache_conv, *w_dw, *b_dw, *ln_g, *ln_b, *g_co; bf16* MIX; float* out; };
__device__ __forceinline__ void conv_unit(lds_u8* lds, const ConvP& P, int trow0, int nrows, int bs  , bool pconv, int tid) {
    LAS unsigned* U = (LAS unsigned*)lds;
    LAS float* RED = (LAS float*)(lds + L_RED); LAS float* RSTD = (LAS float*)(lds + L_RSTD);
    { const int nit = (30 + nrows) * 128; constexpr int UB = 6;
      for (int it0 = tid; it0 < nit; it0 += 512 * UB) {
        u32x2 ga[UB]; f32x4 cu[UB];
#pragma unroll
        for (int q = 0; q < UB; ++q) { const int it = it0 + q * 512, L = it >> 7, c4 = (it & 127) * 4, t = trow0 - 30 + L;
            ga[q] = (u32x2){0u, 0u}; cu[q] = (f32x4){0.f, 0.f, 0.f, 0.f};
            if (it < nit) {
                if (L < 30 && bs >= 0) cu[q] = *(const f32x4*)(P.cache_conv + ((size_t)bs * 30 + L) * 512 + c4);
                else if (L >= 30 || t >= 0) ga[q] = *(const u32x2*)(P.GG + (size_t)t * 512 + c4); } }
#pragma unroll
        for (int q = 0; q < UB; ++q) { const int it = it0 + q * 512, L = it >> 7, c4 = (it & 127) * 4;
            if (it < nit) { u32x2 w = ga[q];
                if (L < 30 && bs >= 0) { w.x = pk2(cu[q].x, cu[q].y); w.y = pk2(cu[q].z, cu[q].w); }
                *(LAS u32x2*)(U + L * 256 + (c4 >> 1)) = w; } }
      } }
    __syncthreads();
    const int cp = tid & 255, rh = tid >> 8, lane = tid & 63;
    f32x2 w[31];
    unsigned co = (unsigned)cp * 8u; asm volatile("" : "+v"(co));
#pragma unroll
    for (int j = 0; j < 31; ++j) w[j] = *(const f32x2*)((const char*)(P.w_dw + j * 512) + co);
    const f32x2 bdw = *(const f32x2*)((const char*)P.b_dw + co), lng = *(const f32x2*)((const char*)P.ln_g + co), lnb = *(const f32x2*)((const char*)P.ln_b + co), gco = *(const f32x2*)((const char*)P.g_co + co);
#pragma unroll 1
    for (int rb = 0; rb < 8; ++rb) {
        const int i0 = rh * 32 + rb * 4;
        if (i0 < nrows) {
            f32x2 acc[4];
#pragma unroll
            for (int i = 0; i < 4; ++i) acc[i] = bdw;
#pragma unroll
            for (int L = 0; L < 34; ++L) { const unsigned pk = U[(i0 + L) * 256 + cp]; const f32x2 uv = {bflo(pk), bfhi(pk)};
#pragma unroll
                for (int i = 0; i < 4; ++i) { const int j = L - i; if (j >= 0 && j <= 30) acc[i] += w[j] * uv; }
                if ((L & 3) == 3) asm volatile("" ::: "memory"); }
#pragma unroll
            for (int i = 0; i < 4; ++i) {
                const float mu = sum32(acc[i].x + acc[i].y) * (1.f / 64.f);
                const float dx = acc[i].x - mu, dy = acc[i].y - mu;
                const float rs = __builtin_amdgcn_rsqf(sum32(dx * dx + dy * dy) * (1.f / 64.f) + EPS);
                const float yx = dx * rs * lng.x + lnb.x, yy = dy * rs * lng.y + lnb.y;
                const float sx = yx * sigm(yx), sy = yy * sigm(yy);
                const float ss = sum32(sx * sx + sy * sy);
                if ((lane & 31) == 0) RED[(i0 + i) * 8 + (cp >> 5)] = ss;
                *(unsigned*)(P.MIX + (size_t)(trow0 + i0 + i) * 1024 + 512 + 2 * cp) = pk2(sx, sy);
            }
        }
    }
    __syncthreads();
    if (tid < 64 && tid < nrows) { float s = 0.f;
#pragma unroll
        for (int g = 0; g < 8; ++g) s += RED[tid * 8 + g];
        RSTD[tid] = rstd_of(s, 512.f); }
    __syncthreads();
    { unsigned pkv[32]; unsigned* mp0 = (unsigned*)(P.MIX + (size_t)(trow0 + rh * 32) * 1024 + 512 + 2 * cp);
#pragma unroll
      for (int i = 0; i < 32; ++i) pkv[i] = (rh * 32 + i < nrows) ? mp0[(size_t)i * 512] : 0u;
#pragma unroll
      for (int i = 0; i < 32; ++i) if (rh * 32 + i < nrows) { const float r = RSTD[rh * 32 + i]; mp0[(size_t)i * 512] = pk2(bflo(pkv[i]) * r * gco.x, bfhi(pkv[i]) * r * gco.y); } }
    __syncthreads();
}

__device__ __forceinline__ void mem_attn_dma_k(lds_u8* lds, const bf16* MK, int h, int slot, int nslots, int lane) {
    const unsigned l0 = (unsigned)(uintptr_t)lds;
    const unsigned krow = (unsigned)lane >> 3, kslt = (unsigned)lane & 7u;
    const unsigned vo0 = krow * 2048u + ((kslt ^ (krow >> 1)) << 4), vo1 = krow * 2048u + ((kslt ^ (4u + (krow >> 1))) << 4);
    for (int pc = slot; pc < 128; pc += nslots) { const int cg = pc >> 5, kg8 = pc & 31;
        glds16s<0>(MK + (size_t)(8 * kg8) * 1024 + h * 256 + cg * 64, (kg8 & 1) ? vo1 : vo0, RFL(l0 + cg * 32768 + kg8 * 1024)); }
}
__device__ __forceinline__ void mem_attn_unit(lds_u8* lds, const bf16* QM, const bf16* MK, const bf16* MV, bf16* O2, int qrow0, int h, int nact, int nstore, int wave, int lane, bool kloaded = false) {
    const int r32 = lane & 31, hi = lane >> 5;
    const unsigned l0 = (unsigned)(uintptr_t)lds;
    LAS float* wsf = (LAS float*)(lds + L_WSF) + wave * 64;
    if (!kloaded) mem_attn_dma_k(lds, MK, h, wave, 8, lane);
    const bool act = wave < nact;
    WAITV(0); __syncthreads();
    f32x16 p[4][2];
    if (act) {
        const bf16* qp = QM + (size_t)(qrow0 + wave * 32 + r32) * 1024 + h * 256 + hi * 8;
#pragma unroll
        for (int half = 0; half < 2; ++half) {
            bf16x8 qr[8];
#pragma unroll
            for (int d = 0; d < 8; ++d) qr[d] = *(const bf16x8*)(qp + (half * 8 + d) * 16);
            const unsigned gk = ((unsigned)r32 >> 1) & 7u;
            unsigned ko0 = (unsigned)(half * 65536 + r32 * 128) + (((0u + hi) ^ gk) << 4), ko1 = (unsigned)(half * 65536 + r32 * 128) + (((2u + hi) ^ gk) << 4),
                     ko2 = (unsigned)(half * 65536 + r32 * 128) + (((4u + hi) ^ gk) << 4), ko3 = (unsigned)(half * 65536 + r32 * 128) + (((6u + hi) ^ gk) << 4);
            asm volatile("" : "+v"(ko0), "+v"(ko1), "+v"(ko2), "+v"(ko3));
#pragma unroll
            for (int kt = 0; kt < 4; ++kt) {
#pragma unroll
                for (int d = 0; d < 8; ++d) { const int d0 = half * 8 + d;
                    const lds_u8* kb = lds + ((d & 3) == 0 ? ko0 : (d & 3) == 1 ? ko1 : (d & 3) == 2 ? ko2 : ko3) + (d >> 2) * 32768 + kt * 8192;
                    const bf16x8 b0 = *(const LAS bf16x8*)kb, b1 = *(const LAS bf16x8*)(kb + 4096);
                    p[kt][0] = __builtin_amdgcn_mfma_f32_32x32x16_bf16(b0, qr[d], d0 == 0 ? f32x16{} : p[kt][0], 0, 0, 0);
                    p[kt][1] = __builtin_amdgcn_mfma_f32_32x32x16_bf16(b1, qr[d], d0 == 0 ? f32x16{} : p[kt][1], 0, 0, 0);
                } }
            __builtin_amdgcn_sched_barrier(0);
        }
    }
    WAITL(); __syncthreads();
    { const unsigned krow = (unsigned)lane >> 3, kslt = (unsigned)lane & 7u, vo = krow * 2048u + ((kslt ^ (((krow >> 1) & 1u) << 1)) << 4);
#pragma unroll
      for (int i = 0; i < 16; ++i) { const int pc = wave * 16 + i, kt = pc >> 5, d64 = (pc >> 3) & 3, kg8 = pc & 7;
          glds16s<0>(MV + (size_t)(kt * 64 + 8 * kg8) * 1024 + h * 256 + d64 * 64, vo, RFL(l0 + (kt * 4 + d64) * 8192 + kg8 * 1024)); } }
    bf16x8 pa[4][4]; float lsum = 0.f;
    if (act) {
        float m = rowmax32(p[0][0], p[0][1]);
#pragma unroll
        for (int kt = 1; kt < 4; ++kt) m = fmaxf(m, rowmax32(p[kt][0], p[kt][1]));
#pragma unroll
        for (int kt = 0; kt < 4; ++kt) {
#pragma unroll
            for (int r = 0; r < 16; ++r) { p[kt][0][r] = __builtin_amdgcn_exp2f(p[kt][0][r] - m); p[kt][1][r] = __builtin_amdgcn_exp2f(p[kt][1][r] - m); lsum += p[kt][0][r] + p[kt][1][r]; }
            pa[kt][0] = packp(p[kt][0], 0); pa[kt][1] = packp(p[kt][0], 8); pa[kt][2] = packp(p[kt][1], 0); pa[kt][3] = packp(p[kt][1], 8);
        }
        lsum = swapsum(lsum);
        if (hi == 0) wsf[r32] = lsum;
    }
    WAITV(0); __syncthreads();
    if (act) {
        float rli[16];
#pragma unroll
        for (int r = 0; r < 16; ++r) rli[r] = 1.0f / wsf[crow(r, hi)];
        const int vb = vb_lane(lane);
#pragma unroll
        for (int dq = 0; dq < 4; ++dq) {
            f32x16 o[2]; o[0] = f32x16{}; o[1] = f32x16{};
            int vbq = vb + dq * 8192; asm volatile("" : "+v"(vbq));
#pragma unroll
            for (int kt = 0; kt < 4; ++kt) pv64(o, lds + vbq + kt * 32768, pa[kt][0], pa[kt][1], pa[kt][2], pa[kt][3]);
            { bf16* ob = O2 + (size_t)(qrow0 + wave * 32) * 1024 + h * 256;
              unsigned lo_ = (unsigned)(4 * hi) * 1024u + (unsigned)r32; asm volatile("" : "+v"(lo_));
#pragma unroll
              for (int r = 0; r < 16; ++r) { const int q0 = (r & 3) + 8 * (r >> 2);
                if (wave * 32 + 4 * hi + q0 < nstore) {
#pragma unroll
                    for (int d0 = 0; d0 < 2; ++d0) ob[lo_ + (unsigned)(q0 * 1024 + dq * 64 + d0 * 32)] = (bf16)(pk2(o[d0][r] * rli[r], 0.f) & 0xffffu); } } }
        }
    }
    WAITL(); __syncthreads();
}

__device__ __forceinline__ f32x4 ld_bf16x4(const bf16* p) { const u32x2 w = *(const u32x2*)p; return (f32x4){bflo(w.x), bfhi(w.x), bflo(w.y), bfhi(w.y)}; }
template <int MODE> __device__ __forceinline__ void thin_phase(const bf16* XN0, float* out, bf16* XB, const bf16* Y, const float* PART, const float* PARTT,
                                                                const float* gpost, float* RS, int gw, int ngw, int lane) {
    for (int row0 = gw; row0 < MTOK; row0 += 2 * ngw) {
        const int rows[2] = {row0, row0 + ngw < MTOK ? row0 + ngw : row0};
        const bool two = row0 + ngw < MTOK;
        float ssp[2]; f32x4 yv[2][4], xv[2][4];
#pragma unroll
        for (int q = 0; q < 2; ++q) { const int row = rows[q];
            ssp[q] = row < SEQ ? PART[(size_t)row * 16 + (lane & 15)] : PARTT[(size_t)(row - SEQ) * 64 + lane];
#pragma unroll
            for (int j = 0; j < 4; ++j) { const int c = 4 * (lane + 64 * j);
                yv[q][j] = ld_bf16x4(Y + (size_t)row * D + c);
                xv[q][j] = ld_bf16x4((MODE == 0 ? XN0 : XB) + (size_t)row * D + c); } }
#pragma unroll
        for (int q = 0; q < 2; ++q) { const int row = rows[q];
            float ss;
            if (row < SEQ) { float s = ssp[q]; s += __shfl_xor(s, 1); s += __shfl_xor(s, 2); s += __shfl_xor(s, 4); s += __shfl_xor(s, 8); ss = s; }
            else ss = wave_sum(ssp[q]);
            const float rs = rstd_of(ss, 1024.f);
            f32x4 v[4]; float s2 = 0.f;
            if (q == 0 || two) {
#pragma unroll
                for (int j = 0; j < 4; ++j) { const int c = 4 * (lane + 64 * j); const f32x4 g = *(const f32x4*)(gpost + c);
                    v[j] = xv[q][j] + yv[q][j] * rs * g; s2 += sq4(v[j]);
                    if (MODE == 2) *(f32x4*)(out + (size_t)row * D + c) = v[j]; else st_bf16x4(XB + (size_t)row * D + c, v[j]); }
                if (MODE != 2) { const float r2 = rstd_of(wave_sum(s2), 1024.f); if (lane == 0) RS[row] = r2; }
            }
        }
    }
}

#define XB_TMO      128
#define XB_XCNT(j)  (256  + 64 * (j))
#define XB_XSUB(j)  (1280 + 64 * (j))
#define XB_XGEN(j)  (2304 + 64 * (j))
#define XB_TOP      3328
#define XB_TOPGEN   3392
#define XCD_BAR_WORDS 3456
#define XB_SPIN_CAP (1u << 18)

__device__ __forceinline__ unsigned xb_ld(unsigned* p)              { return __hip_atomic_load(p, __ATOMIC_RELAXED, __HIP_MEMORY_SCOPE_AGENT); }
__device__ __forceinline__ unsigned xb_add(unsigned* p, unsigned v) { return __hip_atomic_fetch_add(p, v, __ATOMIC_RELAXED, __HIP_MEMORY_SCOPE_AGENT); }
__device__ __forceinline__ unsigned xb_xcc_id() { return (unsigned)__builtin_amdgcn_s_getreg((3 << 11) | 20) & 0xFu; }
#define XB_SPIN(cond, bar) do { unsigned _sp = 0; while (cond) { __builtin_amdgcn_s_sleep(1); \
    if ((++_sp & 255u) == 0u) { if (xb_ld(&(bar)[XB_TMO])) break; if (_sp > XB_SPIN_CAP) { atomicAdd(&(bar)[XB_TMO], 1u); break; } } } } while (0)

struct XcdBarrier {
    unsigned* bar; unsigned x;
    volatile LAS unsigned* st;
};

__device__ __forceinline__ XcdBarrier xcd_barrier_post(unsigned* bar, volatile LAS unsigned* st) {
    XcdBarrier b; b.bar = bar; b.x = xb_xcc_id(); b.st = st;
    if (threadIdx.x == 0) (void)xb_add(&bar[XB_XCNT(b.x)], 1u);
    return b;
}
__device__ __forceinline__ void xcd_barrier_complete(unsigned* bar, unsigned x, unsigned& nloc, unsigned& nx) {
    const unsigned G = gridDim.x * gridDim.y * gridDim.z;
    unsigned sum, cnt, mine, sp = 0u;
    for (;;) {
        sum = 0u; cnt = 0u; mine = 0u;
#pragma unroll
        for (unsigned j = 0; j < 16; ++j) { const unsigned c = xb_ld(&bar[XB_XCNT(j)]); sum += c; cnt += (c > 0u) ? 1u : 0u; mine = (j == x) ? c : mine; }
        if (sum == G) break;
        __builtin_amdgcn_s_sleep(1);
        if ((++sp & 255u) == 0u) { if (xb_ld(&bar[XB_TMO])) break; if (sp > XB_SPIN_CAP) { atomicAdd(&bar[XB_TMO], 1u); break; } }
    }
    nloc = mine > 0u ? mine : 1u; nx = cnt > 0u ? cnt : 1u;
}

__device__ __forceinline__ void xcd_barrier(const XcdBarrier& b) {
    asm volatile("s_waitcnt vmcnt(0)" ::: "memory");
    __syncthreads();
    if (threadIdx.x == 0) {
        unsigned* bar = b.bar;
        __builtin_amdgcn_s_waitcnt(0);
        unsigned nloc = b.st[0], nx = b.st[1];
        if (nloc == 0u) { xcd_barrier_complete(bar, b.x, nloc, nx); b.st[0] = nloc; b.st[1] = nx; }
        const unsigned old = xb_add(&bar[XB_XSUB(b.x)], 1u);
        const unsigned gen = old / nloc;
        if (old + 1u == (gen + 1u) * nloc) {
            __builtin_amdgcn_fence(__ATOMIC_RELEASE, "agent");
            asm volatile("s_waitcnt vmcnt(0)" ::: "memory");
            const unsigned og = xb_add(&bar[XB_TOP], 1u);
            const unsigned tg = og / nx;
            if (og + 1u == (tg + 1u) * nx) xb_add(&bar[XB_TOPGEN], 1u);
            else XB_SPIN(xb_ld(&bar[XB_TOPGEN]) == tg, bar);
            __builtin_amdgcn_fence(__ATOMIC_ACQUIRE, "agent");
            xb_add(&bar[XB_XGEN(b.x)], 1u);
            asm volatile("s_waitcnt vmcnt(0)" ::: "memory");
        } else {
            XB_SPIN(xb_ld(&bar[XB_XGEN(b.x)]) == gen, bar);
            __builtin_amdgcn_fence(__ATOMIC_ACQUIRE, "agent");
            asm volatile("s_waitcnt vmcnt(0)" ::: "memory");
        }
    }
    __syncthreads();
}

template <class Hook> __device__ __forceinline__ void xcd_barrier_hook(const XcdBarrier& b, const Hook& hook) {
    asm volatile("s_waitcnt vmcnt(0)" ::: "memory");
    __syncthreads();
    if (threadIdx.x == 0) {
        unsigned* bar = b.bar;
        __builtin_amdgcn_s_waitcnt(0);
        unsigned nloc = b.st[0], nx = b.st[1];
        if (nloc == 0u) { xcd_barrier_complete(bar, b.x, nloc, nx); b.st[0] = nloc; b.st[1] = nx; }
        const unsigned old = xb_add(&bar[XB_XSUB(b.x)], 1u);
        const unsigned gen = old / nloc;
        if (old + 1u == (gen + 1u) * nloc) {
            __builtin_amdgcn_fence(__ATOMIC_RELEASE, "agent");
            asm volatile("s_waitcnt vmcnt(0)" ::: "memory");
            const unsigned og = xb_add(&bar[XB_TOP], 1u);
            const unsigned tg = og / nx;
            if (og + 1u == (tg + 1u) * nx) xb_add(&bar[XB_TOPGEN], 1u);
            else XB_SPIN(xb_ld(&bar[XB_TOPGEN]) == tg, bar);
            __builtin_amdgcn_fence(__ATOMIC_ACQUIRE, "agent");
            xb_add(&bar[XB_XGEN(b.x)], 1u);
            asm volatile("s_waitcnt vmcnt(0)" ::: "memory");
        } else {
            XB_SPIN(xb_ld(&bar[XB_XGEN(b.x)]) == gen, bar);
            __builtin_amdgcn_fence(__ATOMIC_ACQUIRE, "agent");
            asm volatile("s_waitcnt vmcnt(0)" ::: "memory");
        }
    }
    if (threadIdx.x >= 64) hook();
    __syncthreads();
}

struct Args { const float* in[30]; float* out; unsigned char* ws; int ph_lo, ph_hi; };
__global__ void __launch_bounds__(NWAVES * 64, 2) hybrid_fwd(Args args) {
    extern __shared__ __attribute__((aligned(16))) unsigned char lds_raw[];
    lds_u8* lds = (lds_u8*)lds_raw;
    const int tid = threadIdx.x, lane = tid & 63, wave = __builtin_amdgcn_readfirstlane(tid >> 6);
    const int G = gridDim.x, bx = blockIdx.x;
    const int vcu = (G % 8 == 0) ? (bx % 8) * (G / 8) + bx / 8 : bx;
    const int gw = vcu * NWAVES + wave, ngw = G * NWAVES;
#define PHASE_PTRS const __attribute__((address_space(4))) Args* A_ = (const __attribute__((address_space(4))) Args*)__builtin_amdgcn_kernarg_segment_ptr(); asm volatile("" : "+s"(A_)); \
    unsigned char* ws = A_->ws; float* out = A_->out; \
    bf16 *WUP = (bf16*)(ws + WS_WUP), *WDN = (bf16*)(ws + WS_WDN), *XN = (bf16*)(ws + WS_XN), *KB = (bf16*)(ws + WS_KB), *VB = (bf16*)(ws + WS_VB), *HB = (bf16*)(ws + WS_H), \
         *WIN = (bf16*)(ws + WS_WIN), *WMKV = (bf16*)(ws + WS_WMKV), *WOUT = (bf16*)(ws + WS_WOUT), *WQ = (bf16*)(ws + WS_WQ), *WO = (bf16*)(ws + WS_WO), *MN = (bf16*)(ws + WS_MN), \
         *MKP = (bf16*)(ws + WS_MKP), *MVP = (bf16*)(ws + WS_MVP), *MKS = (bf16*)(ws + WS_MKS), *MVS = (bf16*)(ws + WS_MVS), *QB = (bf16*)(ws + WS_QB), *GG = (bf16*)(ws + WS_GG), \
         *MIX = (bf16*)(ws + WS_MIX), *QM = (bf16*)(ws + WS_QM), *O2 = (bf16*)(ws + WS_O2); \
    bf16 *Y = (bf16*)(ws + WS_Y), *XB = (bf16*)(ws + WS_XB); float *PART = (float*)(ws + WS_PART), *PARTT = (float*)(ws + WS_PARTT), *RS = (float*)(ws + WS_PARTT + 65536); (void)XB; (void)RS; \
    (void)WUP; (void)WDN; (void)XN; (void)KB; (void)VB; (void)HB; (void)WIN; (void)WMKV; (void)WOUT; (void)WQ; (void)WO; (void)MN; (void)MKP; (void)MVP; (void)MKS; (void)MVS; (void)QB; (void)GG; (void)MIX; (void)QM; (void)O2; (void)Y; (void)PART; (void)PARTT; (void)out
    const int lo = args.ph_lo, hi_ph = args.ph_hi;
#ifndef REP2
#define REP2 1
#endif
#ifndef REP6
#define REP6 1
#endif
#ifndef PHMASK
#define PHMASK 0xFFF
#endif
#define IN(k) ((((PHMASK) >> (k)) & 1) && lo <= (k) && (k) < hi_ph)
    volatile LAS unsigned* misc = (volatile LAS unsigned*)(lds + L_MISC);
    if (tid < 4) misc[tid] = 0u;
    __syncthreads();
    XcdBarrier bar; bar.bar = (unsigned*)args.ws; bar.x = 0; bar.st = misc;
    if (hi_ph - lo > 1) bar = xcd_barrier_post((unsigned*)args.ws, misc);
    if (hi_ph - lo > 1) cg::this_grid().sync();
    for (int ec_ = 0; ec_ < REPCG; ++ec_) cg::this_grid().sync();
#define SEAM(k) do { if (IN(k) && IN((k) + 1)) { xcd_barrier(bar); } } while (0)

    if (IN(0)) for (int rep_ = 0; rep_ <= (((REPMASK) >> 0) & 1); ++rep_) { PHASE_PTRS;
        LAS float* scr = (LAS float*)(lds + wave * 16384);
        constexpr int I_IN = 16 * 80, I_SQ = 16 * 32;
        constexpr int NIT = I_IN + 2 * I_SQ;
        for (int it = gw; it < NIT; it += ngw) {
            int r = it;
            if (r < I_IN) { p0_transpose_item<1>(A_->in[9], D, NIN, WIN, 0, scr, r, lane, A_->in[8]); continue; } r -= I_IN;
            if (r < I_SQ) { p0_transpose_item(A_->in[22], D, D, WMKV, 0, scr, r, lane); continue; } r -= I_SQ;
            p0_transpose_item(A_->in[23], D, D, WMKV, D, scr, r, lane);
        }
        for (int m = gw; m < MP; m += 2 * ngw) {
            const int m2 = m + ngw;
#pragma unroll
            for (int q = 0; q < 2; ++q) { const int mm = q == 0 ? m : m2;
                if (mm < MP) {
                    if (mm < MTOK) { const float* xr = mm < SEQ ? A_->in[0] + (size_t)mm * D : A_->in[1] + (size_t)(mm - SEQ) * D;
                        f32x4 v[4]; float s0 = 0.f;
#pragma unroll
                        for (int j = 0; j < 4; ++j) { v[j] = ((const f32x4*)xr)[lane + 64 * j]; s0 += sq4(v[j]); }
#pragma unroll
                        for (int j = 0; j < 4; ++j) st_bf16x4(XN + (size_t)mm * D + 4 * (lane + 64 * j), v[j]);
                        const float r0 = rstd_of(wave_sum(s0), 1024.f); if (lane == 0) RS[mm] = r0; }
                    else { u32x4 z = {0u, 0u, 0u, 0u}; ((u32x4*)(XN + (size_t)mm * D))[lane] = z; ((u32x4*)(XN + (size_t)mm * D))[lane + 64] = z; } } }
        }
        for (int m = gw; m < 256; m += ngw) rms_row_to_bf16(A_->in[2] + (size_t)m * D, A_->in[20], MN + (size_t)m * D, lane);
        WAITV(0); __syncthreads();
    }
    SEAM(0);

    if (IN(1)) for (int rep_ = 0; rep_ <= (((REPMASK) >> 1) & 1); ++rep_) { PHASE_PTRS;
        { pg8::Gemm g{XN, WIN, MP, NIN, D}; pg8::StaticOrder S; S.init(MP, NIN, G, bx);
          EpiRowP<FInProj> E{FInProj{QB, KB, VB, GG, out, RS}};
          pg8::gemm_phase<EpiRowP<FInProj>, pg8::StaticOrder, true, true>(lds, g, S, E); }
        { pg8::Gemm g{MN, WMKV, 256, 2048, D}; OneEach S{G >= 8 ? G - 8 : 0, 8, bx};
          EpiRowP<FMemKV> E{FMemKV{MKP, MVP, out}};
          pg8::gemm_phase<EpiRowP<FMemKV>, OneEach, true, true>(lds, g, S, E); }
        { const int first = 650 - 2 * G, last = G - 8, nidle = last - first;
          if (G == 256 ? (bx >= first && bx < last) : true) {
            const int iw = (G == 256 ? (bx - first) : bx) * NWAVES + wave, niw = (G == 256 ? nidle : G) * NWAVES;
            LAS float* scr = (LAS float*)(lds + wave * 16384);
        for (int it = iw; it < 2 * 8 * KVSEG; it += niw) {
            const int kv = it / (8 * KVSEG), rem = it % (8 * KVSEG), b = rem / KVSEG, r = rem % KVSEG;
            bf16* dst = (kv ? VB : KB) + (size_t)(SEQ + b * KVSEG + r) * 512;
            if (r < 512) { const float* src = (kv ? A_->in[4] : A_->in[3]) + ((size_t)b * 512 + r) * 512;
                const f32x4 a = *(const f32x4*)(src + lane * 8), c = *(const f32x4*)(src + lane * 8 + 4);
                u32x4 w; w.x = pk2(a.x, a.y); w.y = pk2(a.z, a.w); w.z = pk2(c.x, c.y); w.w = pk2(c.z, c.w); *(u32x4*)(dst + lane * 8) = w;
                if (r >= 16) { float* o = out + (kv ? O_SV : O_SK) + ((size_t)b * 512 + (r - 16)) * 512 + lane * 8; *(f32x4*)o = a; *(f32x4*)(o + 4) = c; } }
            else if (r >= 528) { u32x4 z = {0u, 0u, 0u, 0u}; *(u32x4*)(dst + lane * 8) = z; }
        }
        for (int it = iw; it < 8 * 14; it += niw) { const int b = it / 14, r = it % 14;
            const float* src = A_->in[5] + ((size_t)b * 30 + 16 + r) * 512; float* o = out + O_SC + ((size_t)b * 30 + r) * 512;
            *(f32x4*)(o + lane * 8) = *(const f32x4*)(src + lane * 8); *(f32x4*)(o + lane * 8 + 4) = *(const f32x4*)(src + lane * 8 + 4); }
        for (int it = iw; it < 2 * 2048; it += niw) { const int kv = it >> 11, r = it & 2047;
            cvt_row_bf16((kv ? A_->in[7] : A_->in[6]) + (size_t)r * 1024, (kv ? MVS : MKS) + (size_t)r * 1024, 1024, lane); }
            constexpr int I_SQ = 16 * 32, NIT2 = 2 * I_SQ;
            for (int it = iw; it < NIT2; it += niw) {
                int r = it;
                if (r < I_SQ) { p0_transpose_item(A_->in[17], D, D, WOUT, 0, scr, r, lane); continue; } r -= I_SQ;
                p0_transpose_item(A_->in[21], D, D, WQ, 0, scr, r, lane, A_->in[19]);
            }
          } }
    }
    SEAM(1);

    if (IN(2)) for (int rep_ = 0; rep_ <= (((REPMASK) >> 2) & 1); ++rep_) { PHASE_PTRS;
        for (int i = tid; i < 8 * TABS; i += NWAVES * 64) { const int hh = i / TABS, k = i % TABS; ((LAS float*)(lds + L_TAB))[i] = A_->in[10][hh * 257 + (k < 256 ? k : 256)] * LOG2E; }
        __syncthreads();
        const ConvP CP{GG, A_->in[5], A_->in[11], A_->in[12], A_->in[13], A_->in[14], A_->in[16], MIX, out};
#ifndef NO_ATTN
        for (int cc = vcu; cc < 256 * REP2A; cc += G) { const int c = cc & 255;
            if (c >= 8) band_attn_unit<2>(lds, QB, KB, VB, A_->in[15], MIX, 64 * c, 64 * c - 512, 0, false, 64, wave, lane);
            else if (c < 4) {
                band_attn_unit<2>(lds, QB, KB, VB, A_->in[15], MIX, 64 * c, 64 * c - 512, 8 - c, false, 64, wave, lane);
                const int c2 = 7 - c;
                band_attn_unit<2>(lds, QB, KB, VB, A_->in[15], MIX, 64 * c2, 64 * c2 - 512, 8 - c2, false, 64, wave, lane);
            } else {
                for (int sb = 2 * (c - 4); sb < 2 * (c - 4) + 2; ++sb) band_attn_unit<1>(lds, QB, KB, VB, A_->in[15], MIX, SEQ + 16 * sb, SEQ + KVSEG * sb, 0, true, 16, wave, lane);
            }
        }
#endif
#ifndef NO_CONV
        for (int cc = vcu; cc < 256 * REP2 * REP2C; cc += G) { const int c = cc & 255;
            conv_unit(lds, CP, 64 * c, 64, -1, c == 255, tid);
            if (c >= 8 && c < 16) conv_unit(lds, CP, SEQ + 16 * (c - 8), 16, c - 8, false, tid);
        }
#endif
    }
    SEAM(2);

    if (IN(3)) for (int rep_ = 0; rep_ <= (((REPMASK) >> 3) & 1); ++rep_) { PHASE_PTRS;
        const FYStat F{Y, PART, PARTT};
        { pg8::Gemm g{MIX, WOUT, SEQ, D, D}; pg8::StaticOrder S; S.init(SEQ, D, G, bx); EpiRowP<FYStat> E{F};
          pg8::gemm_phase<EpiRowP<FYStat>, pg8::StaticOrder, true, true>(lds, g, S, E); }
        gemm_tail<2, 4>(lds, MIX, WOUT, D, F, wave, lane);
    }
    SEAM(3);
    if (IN(4)) for (int rep_ = 0; rep_ <= (((REPMASK) >> 4) & 1); ++rep_) { PHASE_PTRS; thin_phase<0>(XN, out, XB, Y, PART, PARTT, A_->in[18], RS, gw, ngw, lane); }
    SEAM(4);
    for (int es_ = 0; es_ < REPSYNC; ++es_) SEAM(4);
    if (IN(5)) for (int rep_ = 0; rep_ <= (((REPMASK) >> 5) & 1); ++rep_) { PHASE_PTRS;
        const FScaleBf16 F{QM, 1024, C2M, RS};
        { pg8::Gemm g{XB, WQ, SEQ, D, D}; pg8::StaticOrder S; S.init(SEQ, D, G, bx); EpiRowP<FScaleBf16> E{F};
          pg8::gemm_phase<EpiRowP<FScaleBf16>, pg8::StaticOrder, true, true>(lds, g, S, E); }
        gemm_tail<2, 4>(lds, XB, WQ, D, F, wave, lane);
    }
    bool kpre = false;
    if (IN(5) && IN(6)) { const int u0 = bx;
        if (u0 < 256) { struct KHook { lds_u8* lds; const bf16* MK; int h, wave, lane; __device__ __forceinline__ void operator()() const { mem_attn_dma_k(lds, MK, h, wave - 1, 7, lane); } };
            const KHook hk{lds, (const bf16*)(args.ws + WS_MKP), u0 & 3, wave, lane};
            xcd_barrier_hook(bar, hk); kpre = true; }
        else xcd_barrier(bar); }
    if (IN(6)) for (int rep_ = 0; rep_ <= (((REPMASK) >> 6) & 1); ++rep_) { PHASE_PTRS;
        for (int uu = bx; uu < (256 + 32) * REP6; uu += G) { const int u = uu % 288;
            if (u < 256) mem_attn_unit(lds, QM, MKP, MVP, O2, (u >> 2) * 256, u & 3, 8, 256, wave, lane, kpre && uu == bx);
            else { const int s = u - 256, b = s >> 2; mem_attn_unit(lds, QM, MKS + (size_t)b * 256 * 1024, MVS + (size_t)b * 256 * 1024, O2, SEQ + 16 * b, s & 3, 1, 16, wave, lane); }
        }
        if (G == 256 ? bx >= 32 : true) {
            const int iw = (G == 256 ? bx - 32 : bx) * NWAVES + wave, niw = (G == 256 ? G - 32 : G) * NWAVES;
            LAS float* scr = (LAS float*)(lds + wave * 16384);
            constexpr int I_SQ = 16 * 32, I_UP = 16 * 128, I_DN = 64 * 32, NIT3 = I_SQ + I_UP + I_DN;
            for (int it = iw; it < NIT3; it += niw) {
                int r = it;
                if (r < I_SQ) { p0_transpose_item(A_->in[24], D, D, WO, 0, scr, r, lane); continue; } r -= I_SQ;
                if (r < I_UP) { p0_transpose_item(A_->in[27], D, FF, WUP, 0, scr, r, lane, A_->in[26]); continue; } r -= I_UP;
                p0_transpose_item(A_->in[28], FF, D, WDN, 0, scr, r, lane);
            }
        }
    }
    SEAM(6);
    if (IN(7)) for (int rep_ = 0; rep_ <= (((REPMASK) >> 7) & 1); ++rep_) { PHASE_PTRS;
        const FYStat F{Y, PART, PARTT};
        { pg8::Gemm g{O2, WO, SEQ, D, D}; pg8::StaticOrder S; S.init(SEQ, D, G, bx); EpiRowP<FYStat> E{F};
          pg8::gemm_phase<EpiRowP<FYStat>, pg8::StaticOrder, true, true>(lds, g, S, E); }
        gemm_tail<2, 4>(lds, O2, WO, D, F, wave, lane);
    }
    SEAM(7);
    if (IN(8)) for (int rep_ = 0; rep_ <= (((REPMASK) >> 8) & 1); ++rep_) { PHASE_PTRS; thin_phase<1>(nullptr, out, XB, Y, PART, PARTT, A_->in[25], RS, gw, ngw, lane); }
    SEAM(8);
    if (IN(9)) for (int rep_ = 0; rep_ <= (((REPMASK) >> 9) & 1); ++rep_) { PHASE_PTRS;
        const FRelu2 F{HB, RS};
        { pg8::Gemm g{XB, WUP, SEQ, FF, D}; pg8::StaticOrder S; S.init(SEQ, FF, G, bx); EpiRowP<FRelu2> E{F};
          pg8::gemm_phase<EpiRowP<FRelu2>, pg8::StaticOrder, true, true>(lds, g, S, E); }
        gemm_tail<8, 2>(lds, XB, WUP, D, F, wave, lane);
    }
    SEAM(9);
    if (IN(10)) for (int rep_ = 0; rep_ <= (((REPMASK) >> 10) & 1); ++rep_) { PHASE_PTRS;
        const FYStat F{Y, PART, PARTT};
        { pg8::Gemm g{HB, WDN, SEQ, D, FF}; pg8::StaticOrder S; S.init(SEQ, D, G, bx); EpiRowP<FYStat> E{F};
          pg8::gemm_phase<EpiRowP<FYStat>, pg8::StaticOrder, true, true>(lds, g, S, E); }
        gemm_tail<2, 8>(lds, HB, WDN, FF, F, wave, lane);
    }
    SEAM(10);
    if (IN(11)) for (int rep_ = 0; rep_ <= (((REPMASK) >> 11) & 1); ++rep_) { PHASE_PTRS; thin_phase<2>(nullptr, out, XB, Y, PART, PARTT, A_->in[29], nullptr, gw, ngw, lane); }
#undef IN
#undef SEAM
}

extern "C" void kernel_launch(void* const* d_in, const int* in_sizes, int n_in, void* d_out, int out_size, void* d_ws, size_t ws_size, hipStream_t stream) {
    static int grid = 0;
    if (grid == 0) {
        if (n_in != 30 || ws_size < WS_END) { fprintf(stderr, "kernel_launch: unexpected problem (n_in %d, ws %zu)\n", n_in, ws_size); grid = -1; return; }
        int dev = 0, cus = 0, per_cu = 0;
        (void)hipGetDevice(&dev); (void)hipDeviceGetAttribute(&cus, hipDeviceAttributeMultiprocessorCount, dev);
        (void)hipFuncSetAttribute((const void*)hybrid_fwd, hipFuncAttributeMaxDynamicSharedMemorySize, LDS_BYTES);
        (void)hipOccupancyMaxActiveBlocksPerMultiprocessor(&per_cu, (const void*)hybrid_fwd, NWAVES * 64, LDS_BYTES);
        if (per_cu < 1) { fprintf(stderr, "kernel_launch: occupancy query says %d blocks per CU\n", per_cu); per_cu = 1; }
        (void)hipGetLastError();
        grid = cus * 1;
    }
    if (grid < 0) return;
    Args a{};
    for (int i = 0; i < 30; ++i) a.in[i] = (const float*)d_in[i];
    a.out = (float*)d_out; a.ws = (unsigned char*)d_ws;
#if MK_N_LAUNCHES == 1
    (void)hipMemsetAsync(d_ws, 0, 16384, stream);
    a.ph_lo = 0; a.ph_hi = NPH;
    void* kargs[] = {&a};
    hipError_t e = hipLaunchCooperativeKernel((const void*)hybrid_fwd, dim3(grid), dim3(NWAVES * 64), kargs, LDS_BYTES, stream);
    if (e != hipSuccess) fprintf(stderr, "cooperative launch failed: %s (grid %d)\n", hipGetErrorString(e), grid);
#else
    for (int ph = 0; ph < NPH; ++ph) { a.ph_lo = ph; a.ph_hi = ph + 1; hipLaunchKernelGGL(hybrid_fwd, dim3(grid), dim3(NWAVES * 64), LDS_BYTES, stream, a); }
#endif
}
```
